# Optimizing an MI355X kernel written in HIP

```python
import math
import jax, jax.numpy as jnp
from jax import lax
import numpy as np

D_MODEL = 2048
BATCH = 2
SEQ = 8192
DEPTH = 2

HEAD_DIM = 128
A_HEADS = 4
MOBA_BLOCK = 256
MOBA_TOPK = 3
MOBA_Q_CHUNK = 64
B_HEADS = 4
FOX_Q_BLOCK = 128
CONV_CH = 512
CONV_WIDTH = 31
D_Q_HEADS = 8
D_KV_HEADS = 2
D_HEAD_DIM = 64
WINDOW = 128
N_BUCKETS = 32
MAX_DISTANCE = 1024
N_BIAS_HEADS = A_HEADS + D_Q_HEADS
N_BRANCHES = 4
D_FF = -(-8 * D_MODEL // (3 * 256)) * 256
RMS_EPS = 1e-6
LN_EPS = 1e-5

A_W = A_HEADS * HEAD_DIM
B_W = B_HEADS * HEAD_DIM
D_QW = D_Q_HEADS * D_HEAD_DIM
D_KVW = D_KV_HEADS * D_HEAD_DIM
IN_SPLITS = (A_W, A_W, A_W, B_W, B_W, B_W, B_HEADS, 2 * CONV_CH, D_QW, D_KVW, D_KVW, N_BRANCHES * D_MODEL)
IN_OFFSETS = tuple(int(v) for v in np.cumsum(IN_SPLITS)[:-1])
IN_W = int(sum(IN_SPLITS))

kernel_name = 'hybrid_gated_moba_fox_conformer_swa'


def rms_norm(x, g):
    xf = x.astype(jnp.float32)
    y = xf * lax.rsqrt(jnp.mean(xf * xf, axis=-1, keepdims=True) + RMS_EPS)
    return (y * g.astype(jnp.float32)).astype(x.dtype)


def layer_norm(x, g, b):
    xf = x.astype(jnp.float32)
    mu = jnp.mean(xf, axis=-1, keepdims=True)
    var = jnp.mean(jnp.square(xf - mu), axis=-1, keepdims=True)
    y = (xf - mu) * lax.rsqrt(var + LN_EPS)
    return (y * g.astype(jnp.float32) + b.astype(jnp.float32)).astype(x.dtype)


def t5_bucket(dist):
    max_exact = N_BUCKETS // 2
    d = jnp.maximum(dist, 0)
    log_ratio = jnp.log(jnp.maximum(d, 1).astype(jnp.float32) / max_exact) / math.log(MAX_DISTANCE / max_exact)
    large = max_exact + (log_ratio * (N_BUCKETS - max_exact)).astype(jnp.int32)
    large = jnp.minimum(large, N_BUCKETS - 1)
    return jnp.where(d < max_exact, d, large)


def moba_attention(q, k, v, rel_bias):
    bsz, seq, n_heads, dh = q.shape
    n_blk = -(-seq // MOBA_BLOCK)
    seq_p = n_blk * MOBA_BLOCK
    n_sel = min(MOBA_TOPK, n_blk)
    pad = ((0, 0), (0, seq_p - seq), (0, 0), (0, 0))
    qh = jnp.pad(q, pad).transpose(0, 2, 1, 3)
    k_blocks = jnp.pad(k, pad).transpose(0, 2, 1, 3).reshape(bsz, n_heads, n_blk, MOBA_BLOCK, dh)
    v_blocks = jnp.pad(v, pad).transpose(0, 2, 1, 3).reshape(bsz, n_heads, n_blk, MOBA_BLOCK, dh)
    k_mean = jnp.mean(k_blocks.astype(jnp.float32), axis=3)
    bias_tab = rel_bias.T
    head_ix = jnp.arange(n_heads)[None, :, None, None, None]
    blk_ids = jnp.arange(n_blk)
    offs = jnp.arange(MOBA_BLOCK)
    gather_blocks = jax.vmap(jax.vmap(lambda blocks, idx: blocks[idx]))
    scale = dh ** -0.5

    def one_chunk(ci):
        q0 = ci * MOBA_Q_CHUNK
        qc = lax.dynamic_slice_in_dim(qh, q0, MOBA_Q_CHUNK, axis=2)
        t = q0 + jnp.arange(MOBA_Q_CHUNK)
        own = t // MOBA_BLOCK
        score = jnp.einsum('bhqd,bhnd->bhqn', qc.astype(jnp.float32), k_mean)
        score = jnp.where(blk_ids[None, :] < own[:, None], score, -jnp.inf)
        _, top_i = lax.top_k(score, n_sel)
        own_b = jnp.broadcast_to(own[:, None], top_i.shape[:-1] + (1,))
        blk_idx = jnp.concatenate([top_i, own_b], axis=-1)
        blk_ok = jnp.concatenate([top_i < own[:, None], jnp.ones_like(own_b, dtype=bool)], axis=-1)
        ks = gather_blocks(k_blocks, blk_idx)
        vs = gather_blocks(v_blocks, blk_idx)
        dist = t[:, None, None] - (blk_idx[..., None] * MOBA_BLOCK + offs)
        valid = blk_ok[..., None] & (dist >= 0)
        logits = jnp.einsum('bhqd,bhqnkd->bhqnk', qc, ks, preferred_element_type=jnp.float32) * scale
        logits = logits + bias_tab[head_ix, t5_bucket(dist)].astype(jnp.float32)
        logits = jnp.where(valid, logits, -jnp.inf).reshape(bsz, n_heads, MOBA_Q_CHUNK, -1)
        p = jax.nn.softmax(logits, axis=-1).reshape(valid.shape).astype(vs.dtype)
        return jnp.einsum('bhqnk,bhqnkd->bhqd', p, vs)

    out = lax.map(one_chunk, jnp.arange(seq_p // MOBA_Q_CHUNK))
    out = out.transpose(1, 0, 3, 2, 4).reshape(bsz, seq_p, n_heads * dh)
    return out[:, :seq]


def forgetting_attention(q, k, v, log_f):
    bsz, seq, n_heads, dh = q.shape
    qh = q.transpose(0, 2, 1, 3)
    kh = k.transpose(0, 2, 1, 3)
    vh = v.transpose(0, 2, 1, 3)
    cum = jnp.cumsum(log_f, axis=1).transpose(0, 2, 1)
    kpos = jnp.arange(seq)
    scale = dh ** -0.5

    def one_block(bi):
        q0 = bi * FOX_Q_BLOCK
        qb = lax.dynamic_slice_in_dim(qh, q0, FOX_Q_BLOCK, axis=2)
        cq = lax.dynamic_slice_in_dim(cum, q0, FOX_Q_BLOCK, axis=2)
        t = q0 + jnp.arange(FOX_Q_BLOCK)
        logits = (jnp.einsum('bhqd,bhkd->bhqk', qb, kh, preferred_element_type=jnp.float32) * scale
                  + (cq[..., None] - cum[:, :, None, :]))
        logits = jnp.where(kpos[None, :] <= t[:, None], logits, -jnp.inf)
        p = jax.nn.softmax(logits, axis=-1).astype(vh.dtype)
        return jnp.einsum('bhqk,bhkd->bhqd', p, vh)

    out = lax.map(one_block, jnp.arange(seq // FOX_Q_BLOCK))
    return out.transpose(1, 0, 3, 2, 4).reshape(bsz, seq, n_heads * dh)


def conformer_conv(u, conv_w, conv_b, ln_g, ln_b):
    a, gte = jnp.split(u, 2, axis=-1)
    h = a * jax.nn.sigmoid(gte)
    h = lax.conv_general_dilated(h, conv_w[:, None, :], window_strides=(1,), padding=[(CONV_WIDTH - 1, 0)],
                                 dimension_numbers=('NWC', 'WIO', 'NWC'), feature_group_count=CONV_CH) + conv_b
    return jax.nn.silu(layer_norm(h, ln_g, ln_b))


def sliding_window_attention(q, k, v, sinks, rel_bias):
    bsz, seq, n_q, dh = q.shape
    n_kv = k.shape[2]
    grp = n_q // n_kv
    nb = seq // WINDOW
    qb = q.reshape(bsz, nb, WINDOW, n_kv, grp, dh)

    def band(t):
        prev = jnp.pad(t, ((0, 0), (WINDOW, 0), (0, 0), (0, 0)))[:, :seq]
        return jnp.concatenate([prev.reshape(bsz, nb, WINDOW, n_kv, dh), t.reshape(bsz, nb, WINDOW, n_kv, dh)], axis=2)

    kb, vb = band(k), band(v)
    qi = jnp.arange(WINDOW)[:, None]
    kj = jnp.arange(2 * WINDOW)[None, :]
    dist = qi + WINDOW - kj
    in_win = (dist >= 0) & (dist < WINDOW)
    not_pad = (jnp.arange(nb)[:, None, None] > 0) | (kj >= WINDOW)[None]
    valid = in_win[None] & not_pad
    bias = rel_bias[t5_bucket(dist)].transpose(2, 0, 1).reshape(n_kv, grp, 1, WINDOW, 2 * WINDOW)
    logits = jnp.einsum('bnqhgd,bnkhd->bhgnqk', qb, kb, preferred_element_type=jnp.float32) * (dh ** -0.5)
    logits = jnp.where(valid, logits + bias.astype(jnp.float32), -jnp.inf)
    sink = jnp.broadcast_to(sinks.reshape(n_kv, grp, 1, 1, 1).astype(jnp.float32), logits.shape[:-1] + (1,))
    p = jax.nn.softmax(jnp.concatenate([logits, sink], axis=-1), axis=-1)[..., :-1].astype(vb.dtype)
    out = jnp.einsum('bhgnqk,bnkhd->bnqhgd', p, vb)
    return out.reshape(bsz, seq, n_q * dh)


def hybrid_mixer(h, rel_bias, w_in, fox_b, conv_w, conv_b, conv_g, conv_beta, sinks,
                 w_br_a, w_br_b, w_br_c, w_br_d, w_out):
    bsz, seq, _ = h.shape
    proj = h @ w_in
    aq, ak, av, bq, bk, bv, bf, cu, dq, dk, dv, gl = jnp.split(proj, IN_OFFSETS, axis=-1)

    def heads(t, n):
        return t.reshape(bsz, seq, n, -1)

    ya = moba_attention(heads(aq, A_HEADS), heads(ak, A_HEADS), heads(av, A_HEADS), rel_bias[:, :A_HEADS])
    log_f = jax.nn.log_sigmoid((bf + fox_b).astype(jnp.float32))
    yb = forgetting_attention(heads(bq, B_HEADS), heads(bk, B_HEADS), heads(bv, B_HEADS), log_f)
    yc = conformer_conv(cu, conv_w, conv_b, conv_g, conv_beta)
    yd = sliding_window_attention(heads(dq, D_Q_HEADS), heads(dk, D_KV_HEADS), heads(dv, D_KV_HEADS),
                                  sinks, rel_bias[:, A_HEADS:])
    gates = jax.nn.sigmoid(gl.reshape(bsz, seq, N_BRANCHES, D_MODEL))
    y = (gates[:, :, 0] * (ya @ w_br_a) + gates[:, :, 1] * (yb @ w_br_b)
         + gates[:, :, 2] * (yc @ w_br_c) + gates[:, :, 3] * (yd @ w_br_d))
    return y @ w_out


def swiglu(h, w_gate, w_up, w_down):
    return (jax.nn.silu(h @ w_gate) * (h @ w_up)) @ w_down


def _normal(key, shape, scale):
    return jax.random.normal(key, shape, jnp.float32) * scale


def setup_inputs(seed: int = 0) -> dict:
    key = jax.random.key(seed)
    ks = jax.random.split(key, 24)
    d = D_MODEL
    return {
        'x': _normal(ks[0], (BATCH, SEQ, d), 1.0),
        'c': _normal(ks[1], (BATCH, d), 1.0),
        'rel_bias': _normal(ks[2], (N_BUCKETS, N_BIAS_HEADS), 0.5),
        'w_mod': _normal(ks[3], (DEPTH, d, 6 * d), 0.5 * d ** -0.5),
        'b_mod': _normal(ks[4], (DEPTH, 6 * d), 0.02),
        'mix_norm_pre': 1.0 + _normal(ks[5], (DEPTH, d), 0.05),
        'mix_norm_post': 1.0 + _normal(ks[6], (DEPTH, d), 0.05),
        'w_in': _normal(ks[7], (DEPTH, d, IN_W), d ** -0.5),
        'fox_bias': jax.random.uniform(ks[8], (DEPTH, B_HEADS), jnp.float32, minval=1.0, maxval=4.0),
        'conv_w': _normal(ks[9], (DEPTH, CONV_WIDTH, CONV_CH), CONV_WIDTH ** -0.5),
        'conv_b': _normal(ks[10], (DEPTH, CONV_CH), 0.02),
        'conv_ln_g': 1.0 + _normal(ks[11], (DEPTH, CONV_CH), 0.05),
        'conv_ln_b': _normal(ks[12], (DEPTH, CONV_CH), 0.02),
        'sinks': _normal(ks[13], (DEPTH, D_Q_HEADS), 1.0),
        'w_branch_a': _normal(ks[14], (DEPTH, A_W, d), A_W ** -0.5),
        'w_branch_b': _normal(ks[15], (DEPTH, B_W, d), B_W ** -0.5),
        'w_branch_c': _normal(ks[16], (DEPTH, CONV_CH, d), CONV_CH ** -0.5),
        'w_branch_d': _normal(ks[17], (DEPTH, D_QW, d), D_QW ** -0.5),
        'w_out': _normal(ks[18], (DEPTH, d, d), d ** -0.5),
        'ffn_norm_pre': 1.0 + _normal(ks[19], (DEPTH, d), 0.05),
        'ffn_norm_post': 1.0 + _normal(ks[20], (DEPTH, d), 0.05),
        'w_ffn_gate': _normal(ks[21], (DEPTH, d, D_FF), d ** -0.5),
        'w_ffn_up': _normal(ks[22], (DEPTH, d, D_FF), d ** -0.5),
        'w_ffn_down': _normal(ks[23], (DEPTH, D_FF, d), D_FF ** -0.5),
    }


def reference(x, c, rel_bias, w_mod, b_mod, mix_norm_pre, mix_norm_post, w_in, fox_bias,
              conv_w, conv_b, conv_ln_g, conv_ln_b, sinks, w_branch_a, w_branch_b, w_branch_c,
              w_branch_d, w_out, ffn_norm_pre, ffn_norm_post, w_ffn_gate, w_ffn_up, w_ffn_down):
    c_act = jax.nn.silu(c)
    for l in range(DEPTH):
        mod = c_act @ w_mod[l] + b_mod[l]
        sh_m, sc_m, gt_m, sh_f, sc_f, gt_f = jnp.split(mod[:, None, :], 6, axis=-1)
        h = rms_norm(x, mix_norm_pre[l]) * (1.0 + sc_m) + sh_m
        y = hybrid_mixer(h, rel_bias, w_in[l], fox_bias[l], conv_w[l], conv_b[l], conv_ln_g[l], conv_ln_b[l],
                         sinks[l], w_branch_a[l], w_branch_b[l], w_branch_c[l], w_branch_d[l], w_out[l])
        x = x + gt_m * rms_norm(y, mix_norm_post[l])
        h = rms_norm(x, ffn_norm_pre[l]) * (1.0 + sc_f) + sh_f
        y = swiglu(h, w_ffn_gate[l], w_ffn_up[l], w_ffn_down[l])
        x = x + gt_f * rms_norm(y, ffn_norm_post[l])
    return x
```

```cpp
#include <hip/hip_runtime.h>
#include <cstdio>
#include <cstdint>

#ifndef MK_PER_PHASE
#define MK_PER_PHASE 0
#endif

#ifndef PH_MASK
#define PH_MASK 0xFFFF
#endif
#define PH_EN(k) (((PH_MASK) >> (k)) & 1)
#define GAS __attribute__((address_space(1)))
#define LAS __attribute__((address_space(3)))
typedef unsigned short bf16;
typedef short bf16x8 __attribute__((ext_vector_type(8)));
typedef short s16x4 __attribute__((ext_vector_type(4)));
typedef float f32x4 __attribute__((ext_vector_type(4)));
typedef float f32x2 __attribute__((ext_vector_type(2)));
typedef float f32x16 __attribute__((ext_vector_type(16)));
typedef unsigned u32x4 __attribute__((ext_vector_type(4)));
typedef unsigned u32x2 __attribute__((ext_vector_type(2)));
typedef GAS unsigned gu32;

constexpr int DM = 2048, NBATCH = 2, SEQ = 8192, M = NBATCH * SEQ, DEPTH = 2;
constexpr int DFF = 5632, INW = 13060, INWP = 13056;
constexpr int LDP = 4352;
constexpr int PJ_AQ = 0, PJ_AK = 512, PJ_AV = 1024, PJ_BQ = 1536, PJ_BK = 2048, PJ_BV = 2560, PJ_GLU = 3072, PJ_DQ = 3584, PJ_DK = 4096, PJ_DV = 4224;
constexpr float RMS_EPS = 1e-6f, LN_EPS = 1e-5f, LOG2E = 1.4426950408889634f;
constexpr float C2_128 = 0.08838834764831845f * LOG2E, C2_64 = 0.125f * LOG2E;

constexpr size_t MiB = 1u << 20;
constexpr size_t WS_CTL = 0, CTL_ZERO_BYTES = 1 * MiB;
constexpr size_t WS_MOD = 1 * MiB;
constexpr size_t WS_LF = 1 * MiB + 256 * 1024;
constexpr size_t WS_KB = 1 * MiB + 512 * 1024;
constexpr size_t WS_W = 2 * MiB;
constexpr size_t W_IN = 0, W_BR = 51 * MiB, W_OUT = 59 * MiB, W_GU = 67 * MiB, W_DN = 111 * MiB, W_LAYER = 133 * MiB;
constexpr size_t W_IN8 = W_IN + (size_t)(19 * 256) * DM * 2;
constexpr size_t WS_HY = 268 * MiB;
constexpr size_t WS_PJ = 332 * MiB;
constexpr size_t WS_GT = 468 * MiB;
constexpr size_t WS_BR = 724 * MiB;
constexpr size_t WS_KF = 788 * MiB;
constexpr size_t WS_VF = 804 * MiB;
constexpr size_t WS_XS = 820 * MiB;
constexpr size_t WS_SW = 824 * MiB;
constexpr size_t WS_HS = WS_SW + 96 * 1024;
constexpr size_t WS_HR = WS_SW + 128 * 1024;
constexpr size_t WS_SG = WS_SW + 192 * 1024;
constexpr size_t WS_END = 825 * MiB;
constexpr int CW_BAR = 4096;
constexpr int CW_QUEUE = 8192;
constexpr int CW_KN2 = 12288;
constexpr size_t CTL_XCNT = 128 * 1024;
constexpr size_t CTL_KMEAN = 512 * 1024;

constexpr int RING_BYTES = 131072;
constexpr int MISC_OFF = RING_BYTES + 320;
constexpr int LDS_BYTES = 163840;

#define LDS_WAIT() asm volatile("s_waitcnt lgkmcnt(0)" ::: "memory")
#define VM_WAIT() asm volatile("s_waitcnt vmcnt(0)" ::: "memory")
#define RLX_AGENT __ATOMIC_RELAXED, __HIP_MEMORY_SCOPE_AGENT

typedef __bf16 bf16x2_t __attribute__((ext_vector_type(2)));
__device__ __forceinline__ unsigned cvt_pk_bf16(float lo, float hi) { const f32x2 v = {lo, hi}; const bf16x2_t b = __builtin_convertvector(v, bf16x2_t); return __builtin_bit_cast(unsigned, b); }
__device__ __forceinline__ unsigned f2bf(float f) { unsigned u = __builtin_bit_cast(unsigned, f); return (u + 0x7fffu + ((u >> 16) & 1u)) >> 16; }
__device__ __forceinline__ unsigned pk2(float lo, float hi) { return f2bf(lo) | (f2bf(hi) << 16); }
__device__ __forceinline__ float bf_lo(unsigned w) { return __builtin_bit_cast(float, w << 16); }
__device__ __forceinline__ float bf_hi(unsigned w) { return __builtin_bit_cast(float, w & 0xffff0000u); }
__device__ __forceinline__ float fsigmoid(float x) { return __builtin_amdgcn_rcpf(1.0f + __builtin_amdgcn_exp2f(-x * LOG2E)); }
__device__ __forceinline__ unsigned pk4_i8(float a, float b, float c, float d) {
    const int ia = (int)__builtin_rintf(__builtin_fminf(__builtin_fmaxf(a, -127.f), 127.f)), ib = (int)__builtin_rintf(__builtin_fminf(__builtin_fmaxf(b, -127.f), 127.f));
    const int ic = (int)__builtin_rintf(__builtin_fminf(__builtin_fmaxf(c, -127.f), 127.f)), id = (int)__builtin_rintf(__builtin_fminf(__builtin_fmaxf(d, -127.f), 127.f));
    return (unsigned)(ia & 255) | ((unsigned)(ib & 255) << 8) | ((unsigned)(ic & 255) << 16) | ((unsigned)id << 24);
}
__device__ __forceinline__ unsigned pk4_fp8(float a, float b, float c, float d) { int w = 0; w = __builtin_amdgcn_cvt_pk_fp8_f32(a, b, w, false); w = __builtin_amdgcn_cvt_pk_fp8_f32(c, d, w, true); return (unsigned)w; }
__device__ __forceinline__ int opaque_v(int v) { asm volatile("" : "+v"(v)); return v; }
__device__ __forceinline__ int lane_id_fresh() { int l; asm volatile("v_mbcnt_lo_u32_b32 %0, -1, 0\n\tv_mbcnt_hi_u32_b32 %0, -1, %0" : "=v"(l)); return l; }
template <int M> __device__ __forceinline__ int shx(int v) {
    if constexpr (M < 32) return __builtin_amdgcn_ds_swizzle(v, (M << 10) | 0x1f);
    else return __builtin_amdgcn_ds_bpermute((lane_id_fresh() ^ M) << 2, v);
}
template <int M> __device__ __forceinline__ float shx(float v) { return __builtin_bit_cast(float, shx<M>(__builtin_bit_cast(int, v))); }
template <int M> __device__ __forceinline__ unsigned shx(unsigned v) { return (unsigned)shx<M>((int)v); }
template <int O> __device__ __forceinline__ float shup(float v, int lane) { return __builtin_bit_cast(float, __builtin_amdgcn_ds_bpermute((lane - O) << 2, __builtin_bit_cast(int, v))); }
__device__ __forceinline__ unsigned bid_fresh() { unsigned v = blockIdx.x; asm volatile("" : "+s"(v)); return v; }
__device__ __forceinline__ float wave_sum(float v) {
    v += shx<1>(v); v += shx<2>(v); v += shx<4>(v); v += shx<8>(v); v += shx<16>(v); v += shx<32>(v);
    return v;
}

namespace pg8 {
typedef unsigned short bf16_t;
constexpr int BM = 256, BK = 64, HALF = 128, HTB = HALF * BK * 2, STAGE_BYTES = 8 * HTB, NXCD = 8, WGM = 8;
__host__ __device__ __forceinline__ int lds_byte(int r, int c) { const int st = (r >> 4) * 2 + (c >> 5), rr = r & 15, cc = c & 31, ob = rr * 64 + cc * 2; return st * 1024 + (ob ^ (((ob >> 9) & 1) << 5)); }
__host__ __device__ __forceinline__ void stage_rc(int b, int& R, int& C) { const int st = b / 1024, sb = b % 1024, swz = sb ^ (((sb >> 9) & 1) << 5); R = (st >> 1) * 16 + swz / 64; C = (st & 1) * 32 + (swz % 64) / 2; }
__host__ __device__ __forceinline__ int perm32(int rho) { const int n = rho >> 4, i = rho & 15; return 8 * (i >> 2) + 4 * n + (i & 3); }

struct Unit { int pm, pn, z; };
struct Gemm { const bf16_t* A; const bf16_t* Bt; };
template <int LDA_, int LDB_, int K_, int NM_, int NN_, int Z_, int AZ_, int BZ_, int KSA_ = 128, long APANEL_ = 0> struct Dims { static constexpr int LDA = LDA_, LDB = LDB_, K = K_, NM = NM_, NN = NN_, Z = Z_, AZ = AZ_, BZ = BZ_, KSA = KSA_; static constexpr long APANEL = APANEL_ ? APANEL_ : (long)256 * LDA_ * 2; };

__device__ __forceinline__ void tile_of(int L, int nM, int nN, int& pm, int& pn) {
    const int nwg = nM * nN; int wgid = L;
    { const int q = nwg / NXCD, r = nwg % NXCD, xcd = wgid % NXCD, off = wgid / NXCD; wgid = (xcd < r ? xcd * (q + 1) : r * (q + 1) + (xcd - r) * q) + off; }
    const int nig = WGM * nN, gid = wgid / nig, fm = gid * WGM, gsz = (nM - fm) < WGM ? (nM - fm) : WGM;
    pm = fm + ((wgid % nig) % gsz); pn = (wgid % nig) / gsz;
}
template <class D> struct TileOrder {
    int G, c;
    __device__ __forceinline__ bool next(int i, Unit& u) const {
        const int j = i / D::Z; const int L = j * G + c; if (L >= D::NM * D::NN) return false;
        tile_of(L, D::NM, D::NN, u.pm, u.pn); u.z = i - j * D::Z; return true;
    }
    __device__ __forceinline__ size_t a_off(const Unit& u) const { return (size_t)u.pm * (size_t)D::APANEL + (size_t)u.z * D::AZ; }
    __device__ __forceinline__ size_t b_off(const Unit& u) const { return (size_t)u.pn * ((size_t)256 * D::LDB * 2) + (size_t)u.z * D::BZ; }
};

typedef int i32x4v __attribute__((ext_vector_type(4)));
template <class E, class = void> struct epi_i8 : std::false_type {};
template <class E> struct epi_i8<E, std::void_t<decltype(E::I8)>> : std::bool_constant<E::I8> {};
typedef int i32x8v __attribute__((ext_vector_type(8)));
__device__ __forceinline__ i32x8v cat8(const bf16x8& lo, const bf16x8& hi) { const i32x4v a = __builtin_bit_cast(i32x4v, lo), b = __builtin_bit_cast(i32x4v, hi); return __builtin_shufflevector(a, b, 0, 1, 2, 3, 4, 5, 6, 7); }
template <class D, class Epi, class Sched>
__device__ __forceinline__ void gemm_phase(LAS unsigned char* lds, const Gemm g, const Sched& S, const Epi& E, const int wid) {
    const int lane = lane_id_fresh(), tid = wid * 64 + lane, wr = wid >> 2, wc = wid & 3, fr = lane & 15, fq = lane >> 4;
    constexpr int nt = D::K / BK;
    unsigned voffA[2], voffB[2];
#pragma unroll
    for (int i = 0; i < 2; ++i) { int R, C; stage_rc(tid * 16 + i * 8192, R, C); const int Rb = Epi::PERM ? ((R & ~31) + perm32(R & 31)) : R;
        voffA[i] = (unsigned)(R * D::LDA + C) * 2u; voffB[i] = (unsigned)(Rb * D::LDB + C) * 2u; }
    constexpr size_t kstep = (size_t)(BK * 2), kstepA = (size_t)D::KSA;
    constexpr size_t hstepA = (size_t)HALF * D::LDA * 2, hstepB = (size_t)HALF * D::LDB * 2;
    const unsigned ldsw = (unsigned)wid * 1024u;
    const unsigned ldsb = __builtin_amdgcn_readfirstlane((unsigned)(size_t)lds + ldsw);
    const int aoff = lds_byte(wr * 64 + fr, fq * 8), boff = lds_byte(wc * 32 + fr, fq * 8);
#define PG8_SA(b, h) (((b) * 2 + (h)) * HTB)
#define PG8_SB(b, h) ((4 + (b) * 2 + (h)) * HTB)
#define PG8_STAGE(bufoff, gbase, voff) do { _Pragma("unroll") for (int _i = 0; _i < 2; ++_i) { \
        if constexpr (Epi::F8 || epi_i8<Epi>::value) asm volatile("s_mov_b32 m0, %0\n\ts_nop 0\n\tglobal_load_lds_dwordx4 %1, %2" :: "s"(ldsb + (unsigned)((bufoff) + _i * 8192)), "v"((voff)[_i]), "s"((const char*)(gbase)) : "memory", "m0");   \
        else __builtin_amdgcn_global_load_lds((const unsigned*)((const char*)(gbase) + (voff)[_i]), (LAS unsigned*)(lds + (bufoff) + ldsw + _i * 8192), 16, 0, 0); } } while (0)
#define PG8_LDA(dst, b, h) do { _Pragma("unroll") for (int m = 0; m < 4; ++m) _Pragma("unroll") for (int k = 0; k < 2; ++k) dst[m][k] = *(const LAS bf16x8*)(lds + PG8_SA(b, h) + aoff + m * 2048 + k * 1024); } while (0)
#define PG8_LDB(dst, b, h) do { _Pragma("unroll") for (int n = 0; n < 2; ++n) _Pragma("unroll") for (int k = 0; k < 2; ++k) dst[n][k] = *(const LAS bf16x8*)(lds + PG8_SB(b, h) + boff + n * 2048 + k * 1024); } while (0)
#define PG8_MMA(ai, bj, At, Bt) do { __builtin_amdgcn_s_setprio(1); \
        if constexpr (Epi::F8) { _Pragma("unroll") for (int m = 0; m < 4; ++m) _Pragma("unroll") for (int n = 0; n < 2; ++n) \
            acc[ai][bj][m][n] = __builtin_amdgcn_mfma_scale_f32_16x16x128_f8f6f4(cat8(Bt[n][0], Bt[n][1]), cat8(At[m][0], At[m][1]), acc[ai][bj][m][n], 0, 0, 0, 0, 0, 0); } \
        else if constexpr (epi_i8<Epi>::value) { _Pragma("unroll") for (int m = 0; m < 4; ++m) _Pragma("unroll") for (int n = 0; n < 2; ++n) _Pragma("unroll") for (int k = 0; k < 2; ++k) \
            acc[ai][bj][m][n] = __builtin_bit_cast(f32x4, __builtin_amdgcn_mfma_i32_16x16x64_i8(__builtin_bit_cast(i32x4v, Bt[n][k]), __builtin_bit_cast(i32x4v, At[m][k]), __builtin_bit_cast(i32x4v, acc[ai][bj][m][n]), 0, 0, 0)); } \
        else { _Pragma("unroll") for (int m = 0; m < 4; ++m) _Pragma("unroll") for (int n = 0; n < 2; ++n) _Pragma("unroll") for (int k = 0; k < 2; ++k) \
            acc[ai][bj][m][n] = __builtin_amdgcn_mfma_f32_16x16x32_bf16(Bt[n][k], At[m][k], acc[ai][bj][m][n], 0, 0, 0); } \
        __builtin_amdgcn_s_setprio(0); } while (0)
#define PG8_WAIT_V(n) asm volatile("s_waitcnt vmcnt(" #n ")" ::: "memory")
#define PG8_WAIT_L(n) asm volatile("s_waitcnt lgkmcnt(" #n ")" ::: "memory")
#define PG8_BAR __builtin_amdgcn_s_barrier()
#define PG8_SCHED __builtin_amdgcn_sched_barrier(0)
    Unit cur, nxt; int ui = 0;
    if (!S.next(0, cur)) return;
    f32x4 acc[2][2][4][2];
#pragma unroll
    for (int a = 0; a < 2; ++a)
#pragma unroll
        for (int b = 0; b < 2; ++b)
#pragma unroll
            for (int m = 0; m < 4; ++m)
#pragma unroll
                for (int n = 0; n < 2; ++n) acc[a][b][m][n] = (f32x4){0.f, 0.f, 0.f, 0.f};
    bf16x8 At[4][2], B0[2][2], B1[2][2];
    const char* cA = (const char*)g.A + S.a_off(cur); const char* cB = (const char*)g.Bt + S.b_off(cur);
    PG8_STAGE(PG8_SB(0, 0), cB, voffB); PG8_STAGE(PG8_SB(0, 1), cB + hstepB, voffB); PG8_STAGE(PG8_SA(0, 0), cA, voffA); PG8_STAGE(PG8_SA(0, 1), cA + hstepA, voffA);
    if (wr == 1) PG8_BAR;
    PG8_WAIT_V(2); PG8_BAR;
    PG8_STAGE(PG8_SB(1, 0), cB + kstep, voffB); PG8_STAGE(PG8_SA(1, 0), cA + kstepA, voffA); PG8_STAGE(PG8_SB(1, 1), cB + hstepB + kstep, voffB);
    PG8_WAIT_V(6); PG8_BAR;
    for (;;) {
        const bool has_next = S.next(ui + 1, nxt);
        const char* nA = has_next ? (const char*)g.A + S.a_off(nxt) : cA; const char* nB = has_next ? (const char*)g.Bt + S.b_off(nxt) : cB;
        for (int t = 0; t < nt; t += 2) {
            const bool last = (t == nt - 2);
            const char* a1 = cA + (size_t)(t + 1) * kstepA;
            const char* a2 = last ? nA : cA + (size_t)(t + 2) * kstepA; const char* b2 = last ? nB : cB + (size_t)(t + 2) * kstep;
            const char* a3 = a2 + kstepA; const char* b3 = b2 + kstep;
            PG8_LDB(B0, 0, 0); PG8_LDB(B1, 0, 1); PG8_SCHED; PG8_LDA(At, 0, 0); PG8_STAGE(PG8_SA(1, 1), a1 + hstepA, voffA);
            PG8_WAIT_V(8); PG8_WAIT_L(0); PG8_BAR; PG8_MMA(0, 0, At, B0); PG8_MMA(0, 1, At, B1); PG8_BAR; PG8_SCHED;
            PG8_LDA(At, 0, 1); PG8_STAGE(PG8_SB(0, 0), b2, voffB); PG8_STAGE(PG8_SB(0, 1), b2 + hstepB, voffB); PG8_STAGE(PG8_SA(0, 0), a2, voffA);
            PG8_WAIT_V(8); PG8_WAIT_L(0); PG8_BAR; PG8_MMA(1, 0, At, B0); PG8_MMA(1, 1, At, B1); PG8_BAR; PG8_SCHED;
            PG8_LDB(B0, 1, 0); PG8_LDB(B1, 1, 1); PG8_SCHED; PG8_LDA(At, 1, 0); PG8_STAGE(PG8_SA(0, 1), a2 + hstepA, voffA);
            PG8_WAIT_V(8); PG8_WAIT_L(0); PG8_BAR; PG8_MMA(0, 0, At, B0); PG8_MMA(0, 1, At, B1); PG8_BAR; PG8_SCHED;
            PG8_LDA(At, 1, 1); PG8_STAGE(PG8_SB(1, 0), b3, voffB); PG8_STAGE(PG8_SB(1, 1), b3 + hstepB, voffB); PG8_STAGE(PG8_SA(1, 0), a3, voffA);
            PG8_WAIT_V(8); PG8_WAIT_L(0); PG8_BAR; PG8_MMA(1, 0, At, B0); PG8_MMA(1, 1, At, B1); PG8_BAR; PG8_SCHED;
            if constexpr (Epi::HOOK) { if ((t & 7) == 6 && t != nt - 2) E.mid(acc, cur, t >> 3, wr, wc, fr, fq); }
        }
        if (wr == 0) PG8_BAR;
        if constexpr (!Epi::AFTER_DRAIN) E(acc, cur, wr, wc, fr, fq);
        if (!has_next) break;
#pragma unroll
        for (int a = 0; a < 2; ++a)
#pragma unroll
            for (int b = 0; b < 2; ++b)
#pragma unroll
                for (int m = 0; m < 4; ++m)
#pragma unroll
                    for (int n = 0; n < 2; ++n) acc[a][b][m][n] = (f32x4){0.f, 0.f, 0.f, 0.f};
        cur = nxt; cA = nA; cB = nB; ++ui;
        if (wr == 1) PG8_BAR;
    }
    PG8_WAIT_V(0);
    PG8_BAR;
    if constexpr (Epi::AFTER_DRAIN) E.fused(acc, cur, wr, wc, fr, fq, lds, tid);
#undef PG8_SA
#undef PG8_SB
#undef PG8_STAGE
#undef PG8_LDA
#undef PG8_LDB
#undef PG8_MMA
#undef PG8_WAIT_V
#undef PG8_WAIT_L
#undef PG8_BAR
#undef PG8_SCHED
}

template <bool F8_> struct EpiBf16T {
    static constexpr bool PERM = true, HOOK = false, AFTER_DRAIN = false, F8 = F8_;
    bf16_t* O; int ldc;
    __device__ __forceinline__ void operator()(const f32x4 (&acc)[2][2][4][2], const Unit& u, int wr, int wc, int fr, int fq) const {
        if constexpr (F8_) { const int t = lane_id_fresh(); fr = t & 15; fq = t >> 4; }
        const int row0 = u.pm * BM + wr * 64 + fr, col0 = u.pn * BM + wc * 32 + 8 * fq;
        constexpr float SC = F8_ ? (1.0f / 64.0f) : 1.0f;
#pragma unroll
        for (int ai = 0; ai < 2; ++ai)
#pragma unroll
            for (int m = 0; m < 4; ++m) { bf16_t* rowp = O + (size_t)(row0 + ai * HALF + m * 16) * ldc + col0;
#pragma unroll
                for (int bj = 0; bj < 2; ++bj) { const f32x4 v0 = acc[ai][bj][m][0] * SC, v1 = acc[ai][bj][m][1] * SC;
                    u32x4 w; w.x = cvt_pk_bf16(v0[0], v0[1]); w.y = cvt_pk_bf16(v0[2], v0[3]); w.z = cvt_pk_bf16(v1[0], v1[1]); w.w = cvt_pk_bf16(v1[2], v1[3]);
                    *(u32x4*)(rowp + bj * HALF) = w; } }
    }
};
typedef EpiBf16T<false> EpiBf16;
struct EpiSwiGLU {
    static constexpr bool PERM = true, HOOK = false, AFTER_DRAIN = false, F8 = false, I8 = true;
    bf16_t* O; int ldc; const float* sw; const float* hs;
    __device__ __forceinline__ void operator()(const f32x4 (&acc)[2][2][4][2], const Unit& u, int wr, int wc, int fr, int fq) const {
        const int col0 = u.pn * HALF + wc * 32 + 8 * fq;
        bf16_t* tile = O + (((size_t)u.pm * (ldc / 64) + (col0 >> 6)) * 256 + wr * 64 + fr) * 64 + (col0 & 63);
        const float sh = hs[u.pm >> 5];
        const float* swp = sw + u.pn * BM + wc * 32 + 8 * fq;
        f32x4 sg[2], su[2];
#pragma unroll
        for (int n = 0; n < 2; ++n) { sg[n] = *(const f32x4*)(swp + 4 * n) * sh; su[n] = *(const f32x4*)(swp + HALF + 4 * n) * sh; }
#pragma unroll
        for (int ai = 0; ai < 2; ++ai)
#pragma unroll
            for (int m = 0; m < 4; ++m) { bf16_t* rowp = tile + (size_t)(ai * HALF + m * 16) * 64;
                float o[8];
#pragma unroll
                for (int n = 0; n < 2; ++n)
#pragma unroll
                    for (int j = 0; j < 4; ++j) { const float ag = acc[ai][0][m][n][j], au = acc[ai][1][m][n][j];
                        const float gg = (float)__float_as_int(ag) * sg[n][j], uu = (float)__float_as_int(au) * su[n][j]; o[n * 4 + j] = gg * fsigmoid(gg) * uu; }
                u32x4 w; w.x = cvt_pk_bf16(o[0], o[1]); w.y = cvt_pk_bf16(o[2], o[3]); w.z = cvt_pk_bf16(o[4], o[5]); w.w = cvt_pk_bf16(o[6], o[7]);
                __builtin_nontemporal_store(w, (u32x4*)rowp); }
    }
};
struct EpiProj {
    static constexpr bool PERM = true, HOOK = false, AFTER_DRAIN = false, F8 = false, I8 = true;
    bf16_t* PJ; bf16_t* GT; bf16_t* KF; bf16_t* VF; float* kmean; unsigned* kn2;
    const float* hr; const float* sg;
    __device__ __forceinline__ void operator()(const f32x4 (&acci)[2][2][4][2], const Unit& u, int wr, int wc, int fr, int fq) const {
        const int pn = u.pn, row0 = u.pm * BM + wr * 64 + fr, cw = wc * 32 + 8 * fq;
        f32x4 acc[2][2][4][2];
        { f32x4 cs[2][2]; float rs8[2][4];
#pragma unroll
            for (int bj = 0; bj < 2; ++bj)
#pragma unroll
                for (int n = 0; n < 2; ++n) cs[bj][n] = *(const f32x4*)(sg + pn * BM + bj * HALF + cw + 4 * n);
#pragma unroll
            for (int ai = 0; ai < 2; ++ai)
#pragma unroll
                for (int m = 0; m < 4; ++m) rs8[ai][m] = hr[(size_t)row0 + ai * HALF + m * 16];
#pragma unroll
            for (int ai = 0; ai < 2; ++ai)
#pragma unroll
                for (int bj = 0; bj < 2; ++bj)
#pragma unroll
                    for (int m = 0; m < 4; ++m)
#pragma unroll
                        for (int n = 0; n < 2; ++n)
#pragma unroll
                            for (int j = 0; j < 4; ++j) { const float a = acci[ai][bj][m][n][j]; acc[ai][bj][m][n][j] = (float)__float_as_int(a) * (rs8[ai][m] * cs[bj][n][j]); } }
        if (pn >= 12 && pn < 16) {
            bf16_t* base = PJ + PJ_GLU + (pn - 12) * HALF + cw;
#pragma unroll
            for (int ai = 0; ai < 2; ++ai)
#pragma unroll
                for (int m = 0; m < 4; ++m) { bf16_t* rowp = base + (size_t)(row0 + ai * HALF + m * 16) * LDP;
                    float o[8];
#pragma unroll
                    for (int n = 0; n < 2; ++n)
#pragma unroll
                        for (int j = 0; j < 4; ++j) o[n * 4 + j] = acc[ai][0][m][n][j] * fsigmoid(acc[ai][1][m][n][j]);
                    u32x4 w; w.x = cvt_pk_bf16(o[0], o[1]); w.y = cvt_pk_bf16(o[2], o[3]); w.z = cvt_pk_bf16(o[4], o[5]); w.w = cvt_pk_bf16(o[6], o[7]);
                    *(u32x4*)rowp = w; }
        } else {
            const int col = pn < 12 ? pn * BM : PJ_DQ + (pn - 16) * BM;
            const float sc = (pn < 2 || pn == 6 || pn == 7) ? C2_128 : ((pn == 16 || pn == 17) ? C2_64 : 1.0f);
            if (pn == 2 || pn == 3) {
                const int bb = u.pm >> 5, g32 = 8 * (u.pm & 31) + 2 * wr;
#pragma unroll
                for (int ai = 0; ai < 2; ++ai)
#pragma unroll
                    for (int m = 0; m < 4; ++m)
#pragma unroll
                        for (int bj = 0; bj < 2; ++bj) { const f32x4 v0 = acc[ai][bj][m][0], v1 = acc[ai][bj][m][1];
                            const int hh = (pn - 2) * 2 + bj;
                            bf16_t* dst = KF + ((((size_t)((bb * 4 + hh) * 256 + g32 + 4 * ai + (m >> 1)) * 8 + 2 * wc + (fq >> 1)) * 2 + (fq & 1)) * 32 + 16 * (m & 1) + fr) * 8;
                            u32x4 w; w.x = cvt_pk_bf16(v0[0], v0[1]); w.y = cvt_pk_bf16(v0[2], v0[3]); w.z = cvt_pk_bf16(v1[0], v1[1]); w.w = cvt_pk_bf16(v1[2], v1[3]);
                            *(u32x4*)dst = w; }
            } else if (pn == 4 || pn == 5) {
                const int bb = u.pm >> 5, g16 = 16 * (u.pm & 31) + 4 * wr;
#pragma unroll
                for (int ai = 0; ai < 2; ++ai)
#pragma unroll
                    for (int m = 0; m < 4; ++m)
#pragma unroll
                        for (int bj = 0; bj < 2; ++bj) { const int hh = (pn - 4) * 2 + bj;
                            bf16_t* dst = VF + ((((size_t)((bb * 4 + hh) * 512 + g16 + 8 * ai + m) * 4 + wc) * 2 + (fr >> 3)) * 32 + 8 * fq) * 8 + (fr & 7);
#pragma unroll
                            for (int n = 0; n < 2; ++n)
#pragma unroll
                                for (int j = 0; j < 4; ++j) { const float v = acc[ai][bj][m][n][j]; dst[(4 * n + j) * 8] = (bf16_t)(cvt_pk_bf16(v, v) & 0xffffu); } }
            } else {
            bf16_t* base = PJ + col + cw;
#pragma unroll
            for (int ai = 0; ai < 2; ++ai)
#pragma unroll
                for (int m = 0; m < 4; ++m) { bf16_t* rowp = base + (size_t)(row0 + ai * HALF + m * 16) * LDP;
#pragma unroll
                    for (int bj = 0; bj < 2; ++bj) { const f32x4 v0 = acc[ai][bj][m][0] * sc, v1 = acc[ai][bj][m][1] * sc;
                        u32x4 w; w.x = cvt_pk_bf16(v0[0], v0[1]); w.y = cvt_pk_bf16(v0[2], v0[3]); w.z = cvt_pk_bf16(v1[0], v1[1]); w.w = cvt_pk_bf16(v1[2], v1[3]);
                        *(u32x4*)(rowp + bj * HALF) = w; } }
            }
            if (pn == 8 || pn == 9) {
#pragma unroll
                for (int bj = 0; bj < 2; ++bj) { float mx = 0.f;
#pragma unroll
                    for (int ai = 0; ai < 2; ++ai)
#pragma unroll
                        for (int m = 0; m < 4; ++m) { const f32x4 a0 = acc[ai][bj][m][0], a1 = acc[ai][bj][m][1];
                            float q = (a0[0] * a0[0] + a0[1] * a0[1]) + (a0[2] * a0[2] + a0[3] * a0[3]) + (a1[0] * a1[0] + a1[1] * a1[1]) + (a1[2] * a1[2] + a1[3] * a1[3]);
                            q += shx<16>(q); q += shx<32>(q); mx = fmaxf(mx, q); }
                    mx = fmaxf(mx, shx<1>(mx)); mx = fmaxf(mx, shx<2>(mx)); mx = fmaxf(mx, shx<4>(mx)); mx = fmaxf(mx, shx<8>(mx));
                    if (fr == 0 && fq == 0) atomicMax(kn2 + ((u.pm >> 5) * 4 + (pn - 8) * 2 + bj) * 64, __float_as_uint(mx)); }
            }
            if (pn == 2 || pn == 3) {
                float* kp = kmean + (size_t)u.pm * 512 + (pn - 2) * BM + cw;
#pragma unroll
                for (int bj = 0; bj < 2; ++bj)
#pragma unroll
                    for (int n = 0; n < 2; ++n)
#pragma unroll
                        for (int j = 0; j < 4; ++j) { float s = 0.f;
#pragma unroll
                            for (int ai = 0; ai < 2; ++ai)
#pragma unroll
                                for (int m = 0; m < 4; ++m) s += acc[ai][bj][m][n][j];
                            s += shx<1>(s); s += shx<2>(s); s += shx<4>(s); s += shx<8>(s);
                            if (fr == 0) unsafeAtomicAdd(kp + bj * HALF + n * 4 + j, s); }
            }
        }
    }
};
struct EpiGate8 {
    static constexpr bool PERM = true, HOOK = false, AFTER_DRAIN = false, F8 = false, I8 = true;
    bf16_t* GT; const float* hr; const float* sg;
    __device__ __forceinline__ void operator()(const f32x4 (&acc)[2][2][4][2], const Unit& u, int wr, int wc, int fr, int fq) const {
        f32x4 cs[2][2];
#pragma unroll
        for (int bj = 0; bj < 2; ++bj)
#pragma unroll
            for (int n = 0; n < 2; ++n) cs[bj][n] = *(const f32x4*)(sg + u.pn * BM + bj * HALF + wc * 32 + 8 * fq + 4 * n) * (-LOG2E);
        float rs8[2][4];
#pragma unroll
        for (int ai = 0; ai < 2; ++ai)
#pragma unroll
            for (int m = 0; m < 4; ++m) rs8[ai][m] = hr[(size_t)u.pm * BM + ai * HALF + wr * 64 + m * 16 + fr];
        asm volatile("" ::: "memory");
        unsigned char* base = (unsigned char*)GT + ((size_t)u.pm * 32 + u.pn) * 65536 + (size_t)((unsigned)((wr * 4 + wc) * 64 + lane_id_fresh()) * 16u);
#pragma unroll
        for (int ai = 0; ai < 2; ++ai)
#pragma unroll
            for (int m = 0; m < 4; ++m) { u32x4 w; const float rs = rs8[ai][m];
#pragma unroll
                for (int bj = 0; bj < 2; ++bj) { const f32x4 v0 = acc[ai][bj][m][0], v1 = acc[ai][bj][m][1];
                    unsigned q[8];
#pragma unroll
                    for (int k = 0; k < 4; ++k) { const float a0 = v0[k], a1 = v1[k];
                        q[k] = (unsigned)fmaxf(__builtin_amdgcn_rcpf(1.0f + __builtin_amdgcn_exp2f((float)__float_as_int(a0) * (rs * cs[bj][0][k]))) * 255.0f + 0.5f, 1.0f);
                        q[4 + k] = (unsigned)fmaxf(__builtin_amdgcn_rcpf(1.0f + __builtin_amdgcn_exp2f((float)__float_as_int(a1) * (rs * cs[bj][1][k]))) * 255.0f + 0.5f, 1.0f); }
                    const unsigned lo = q[0] | (q[1] << 8) | (q[2] << 16) | (q[3] << 24), hi = q[4] | (q[5] << 8) | (q[6] << 16) | (q[7] << 24);
                    if (bj == 0) { w.x = lo; w.y = hi; } else { w.z = lo; w.w = hi; } }
                __builtin_nontemporal_store(w, (u32x4*)(base + (ai * 4 + m) * 8192)); }
    }
};
struct EpiMerge {
    static constexpr bool PERM = true, HOOK = true, AFTER_DRAIN = false, F8 = false;
    const unsigned char* GT; bf16_t* Y;
    __device__ __forceinline__ void mid(f32x4 (&acc)[2][2][4][2], const Unit& u, int z, int wr, int wc, int fr, int fq) const {
        const unsigned lin = (unsigned)opaque_v(((wr * 4 + wc) * 64 + fq * 16 + fr));
        const unsigned char* t0 = GT + ((size_t)u.pm * 32 + z * 8 + u.pn) * 65536;
#pragma unroll
        for (int ai = 0; ai < 2; ++ai) {
            u32x4 ga[4], gb[4];
#pragma unroll
            for (int m = 0; m < 4; ++m) { ga[m] = *(const u32x4*)(t0 + lin * 16u + (ai * 4 + m) * 8192); gb[m] = *(const u32x4*)(t0 + 8 * 65536 + lin * 16u + (ai * 4 + m) * 8192); }
            asm volatile("" ::: "memory");
#pragma unroll
            for (int m = 0; m < 4; ++m)
#pragma unroll
                for (int bj = 0; bj < 2; ++bj) { const u32x2 a = bj ? (u32x2){ga[m].z, ga[m].w} : (u32x2){ga[m].x, ga[m].y}, b = bj ? (u32x2){gb[m].z, gb[m].w} : (u32x2){gb[m].x, gb[m].y};
#pragma unroll
                    for (int k = 0; k < 4; ++k) { const float na = (float)((a.x >> (8 * k)) & 255u), nb = (float)((b.x >> (8 * k)) & 255u), nc = (float)((a.y >> (8 * k)) & 255u), nd = (float)((b.y >> (8 * k)) & 255u);
                        acc[ai][bj][m][0][k] *= na * __builtin_amdgcn_rcpf(nb); acc[ai][bj][m][1][k] *= nc * __builtin_amdgcn_rcpf(nd); } }
            asm volatile("" ::: "memory");
        }
    }
    __device__ __forceinline__ void operator()(const f32x4 (&acc)[2][2][4][2], const Unit& u, int wr, int wc, int fr, int fq) const {
        const int row0 = u.pm * BM + wr * 64 + fr, col0 = u.pn * BM + wc * 32 + 8 * fq;
        const unsigned lin = (unsigned)opaque_v(((wr * 4 + wc) * 64 + fq * 16 + fr));
        const unsigned char* t3 = GT + ((size_t)u.pm * 32 + 3 * 8 + u.pn) * 65536;
#pragma unroll
        for (int ai = 0; ai < 2; ++ai) {
            u32x4 gw[4];
#pragma unroll
            for (int m = 0; m < 4; ++m) gw[m] = *(const u32x4*)(t3 + lin * 16u + (ai * 4 + m) * 8192);
            asm volatile("" ::: "memory");
#pragma unroll
            for (int m = 0; m < 4; ++m)
#pragma unroll
                for (int bj = 0; bj < 2; ++bj) { const u32x2 g = bj ? (u32x2){gw[m].z, gw[m].w} : (u32x2){gw[m].x, gw[m].y};
                    const f32x4 v0 = acc[ai][bj][m][0] * (1.0f / 255.0f), v1 = acc[ai][bj][m][1] * (1.0f / 255.0f);
                    u32x4 w;
                    w.x = cvt_pk_bf16((float)(g.x & 255u) * v0[0], (float)((g.x >> 8) & 255u) * v0[1]);
                    w.y = cvt_pk_bf16((float)((g.x >> 16) & 255u) * v0[2], (float)(g.x >> 24) * v0[3]);
                    w.z = cvt_pk_bf16((float)(g.y & 255u) * v1[0], (float)((g.y >> 8) & 255u) * v1[1]);
                    w.w = cvt_pk_bf16((float)((g.y >> 16) & 255u) * v1[2], (float)(g.y >> 24) * v1[3]);
                    *(u32x4*)(Y + (size_t)(row0 + ai * HALF + m * 16) * DM + col0 + bj * HALF) = w; }
            asm volatile("" ::: "memory");
        }
    }
};

template <class D> struct SliceOrder {
    int slice, c;
    __device__ __forceinline__ bool next(int i, Unit& u) const { if (i > 0) return false; u.pm = slice * 32 + (c & 7) * 4 + ((c >> 3) & 3); u.pn = c >> 5; u.z = 0; return true; }
    __device__ __forceinline__ size_t a_off(const Unit& u) const { return (size_t)u.pm * (size_t)D::APANEL; }
    __device__ __forceinline__ size_t b_off(const Unit& u) const { return (size_t)u.pn * ((size_t)256 * D::LDB * 2); }
};
struct RowX {
    float* slots; gu32* cnt; gu32* tmo;
    static constexpr int XOFF = RING_BYTES + 4096;
    __device__ __forceinline__ void publish(const float (&part)[2][4], const Unit& u, int wr, int wc, int fr, int fq, LAS unsigned char* lds, int tid) const {
        LAS float* P = (LAS float*)(lds + XOFF);
#pragma unroll
        for (int ai = 0; ai < 2; ++ai)
#pragma unroll
            for (int m = 0; m < 4; ++m) { float v = part[ai][m]; v += shx<16>(v); v += shx<32>(v); if (fq == 0) P[(ai * HALF + wr * 64 + m * 16 + fr) * 4 + wc] = v; }
        asm volatile("s_waitcnt lgkmcnt(0)" ::: "memory"); __builtin_amdgcn_s_barrier(); asm volatile("" ::: "memory");
        if (tid < 256) { const float t = (P[tid * 4 + 0] + P[tid * 4 + 1]) + (P[tid * 4 + 2] + P[tid * 4 + 3]);
            __hip_atomic_store((unsigned*)slots + ((size_t)u.pm * 256 + tid) * 8 + u.pn, __float_as_uint(t), __ATOMIC_RELAXED, __HIP_MEMORY_SCOPE_AGENT); }
        asm volatile("s_waitcnt vmcnt(0)" ::: "memory"); __builtin_amdgcn_s_barrier(); asm volatile("" ::: "memory");
        if (tid == 0) __hip_atomic_fetch_add(cnt + 16 * u.pm, 1u, __ATOMIC_RELAXED, __HIP_MEMORY_SCOPE_AGENT);
    }
    __device__ __forceinline__ void collect(const Unit& u, LAS unsigned char* lds, int tid) const {
        LAS float* S = (LAS float*)(lds + XOFF + 4096);
        if (tid == 0) { unsigned sp = 0; while (__hip_atomic_load(cnt + 16 * u.pm, __ATOMIC_RELAXED, __HIP_MEMORY_SCOPE_AGENT) < 8u) { __builtin_amdgcn_s_sleep(1); if (++sp > (1u << 20)) { __hip_atomic_store(tmo, 1u, __ATOMIC_RELAXED, __HIP_MEMORY_SCOPE_AGENT); break; } }
            __builtin_amdgcn_fence(__ATOMIC_ACQUIRE, "agent"); asm volatile("s_waitcnt vmcnt(0)" ::: "memory"); }
        __builtin_amdgcn_s_barrier(); asm volatile("" ::: "memory");
        if (tid < 256) { const f32x4 a = *(const f32x4*)(slots + ((size_t)u.pm * 256 + tid) * 8), b = *(const f32x4*)(slots + ((size_t)u.pm * 256 + tid) * 8 + 4);
            const float t = ((a.x + a.y) + (a.z + a.w)) + ((b.x + b.y) + (b.z + b.w)); S[tid] = 1.0f / sqrtf(t * (1.0f / 2048.0f) + 1e-6f); }
        asm volatile("s_waitcnt vmcnt(0) lgkmcnt(0)" ::: "memory"); __builtin_amdgcn_s_barrier(); asm volatile("" ::: "memory");
    }
};
struct EpiResNorm {
    static constexpr bool PERM = true, HOOK = false, AFTER_DRAIN = true, F8 = false;
    const float* xf32; const bf16_t* xb; int xb_pitch, xb_off;
    bf16_t* xo; int xo_pitch, xo_off; float* outf;
    const float* res_gate; const float* res_gain;
    bf16_t* hout; const float* nx_gain; const float* nx_scale; const float* nx_shift; const float* hs;
    RowX ex1, ex2;
    __device__ __forceinline__ void stage_x(int ai, const Unit& u, int wid, int lane, LAS unsigned char* lds) const {
        const size_t grow0 = (size_t)u.pm * BM + ai * HALF;
        if (xf32) {
#pragma unroll
            for (int j = 0; j < 16; ++j) { const int r = j * 8 + wid; const int ch = lane ^ (r & 15);
                __builtin_amdgcn_global_load_lds((const unsigned*)(xf32 + (grow0 + r) * DM + u.pn * BM + ch * 4), (LAS unsigned*)(lds + r * 1024), 16, 0, 0); }
        } else {
#pragma unroll
            for (int j = 0; j < 8; ++j) { const int r = 2 * (j * 8 + wid) + (lane >> 5); const int ch = (lane & 31) ^ (r & 15);
                __builtin_amdgcn_global_load_lds((const unsigned*)(xb + (grow0 + r) * xb_pitch + xb_off + u.pn * BM + ch * 8), (LAS unsigned*)(lds + ai * 65536 + (j * 8 + wid) * 1024), 16, 0, 0); }
        }
    }
    __device__ __forceinline__ void residual_half(int ai, f32x4 (&acc)[2][2][4][2], float (&part)[2][4], const f32x4 (&g1)[2][2], const Unit& u, int wr, int wc, int fr, int fq, LAS unsigned char* lds) const {
        const LAS float* S = (const LAS float*)(lds + RowX::XOFF + 4096);
        const int col0 = u.pn * BM + wc * 32 + 8 * fq;
#pragma unroll
        for (int m = 0; m < 4; ++m) { const int rh = wr * 64 + m * 16 + fr, rl = ai * HALF + rh; const float r = S[rl]; const size_t grow = (size_t)u.pm * BM + rl; float q = 0.f;
#pragma unroll
            for (int bj = 0; bj < 2; ++bj) { const int c = col0 + bj * HALF;
                f32x4 x0, x1;
                if (xf32) { const int q0 = bj * 32 + wc * 8 + fq * 2; const LAS unsigned char* p = lds + rh * 1024; x0 = *(const LAS f32x4*)(p + ((q0 ^ fr) << 4)); x1 = *(const LAS f32x4*)(p + (((q0 + 1) ^ fr) << 4)); }
                else { const u32x4 w = *(const LAS u32x4*)(lds + ai * 65536 + rh * 512 + (((bj * 16 + wc * 4 + fq) ^ fr) << 4)); x0 = (f32x4){bf_lo(w.x), bf_hi(w.x), bf_lo(w.y), bf_hi(w.y)}; x1 = (f32x4){bf_lo(w.z), bf_hi(w.z), bf_lo(w.w), bf_hi(w.w)}; }
                f32x4 v0 = x0 + g1[bj][0] * (acc[ai][bj][m][0] * r), v1 = x1 + g1[bj][1] * (acc[ai][bj][m][1] * r);
                if (xo) { u32x4 w; w.x = cvt_pk_bf16(v0.x, v0.y); w.y = cvt_pk_bf16(v0.z, v0.w); w.z = cvt_pk_bf16(v1.x, v1.y); w.w = cvt_pk_bf16(v1.z, v1.w);
                    *(u32x4*)(xo + grow * xo_pitch + xo_off + c) = w;
                    v0 = (f32x4){bf_lo(w.x), bf_hi(w.x), bf_lo(w.y), bf_hi(w.y)}; v1 = (f32x4){bf_lo(w.z), bf_hi(w.z), bf_lo(w.w), bf_hi(w.w)}; }
                else { *(f32x4*)(outf + grow * DM + c) = v0; *(f32x4*)(outf + grow * DM + c + 4) = v1; }
                acc[ai][bj][m][0] = v0; acc[ai][bj][m][1] = v1;
                q += (v0.x * v0.x + v0.y * v0.y) + (v0.z * v0.z + v0.w * v0.w) + (v1.x * v1.x + v1.y * v1.y) + (v1.z * v1.z + v1.w * v1.w); }
            part[ai][m] = q;
            if (m & 1) asm volatile("" ::: "memory"); }
    }
    __device__ __forceinline__ void fused(f32x4 (&acc)[2][2][4][2], const Unit& u, int wr, int wc, int fr, int fq, LAS unsigned char* lds, int tid) const {
        const LAS float* S = (const LAS float*)(lds + RowX::XOFF + 4096);
        const int bt = u.pm >> 5, col0 = u.pn * BM + wc * 32 + 8 * fq, wid = wr * 4 + wc, lane = fq * 16 + fr;
        float part[2][4];
#pragma unroll
        for (int ai = 0; ai < 2; ++ai)
#pragma unroll
            for (int m = 0; m < 4; ++m) { float q = 0.f;
#pragma unroll
                for (int bj = 0; bj < 2; ++bj)
#pragma unroll
                    for (int n = 0; n < 2; ++n) { const f32x4 v = acc[ai][bj][m][n]; q += (v.x * v.x + v.y * v.y) + (v.z * v.z + v.w * v.w); }
                part[ai][m] = q; }
        ex1.publish(part, u, wr, wc, fr, fq, lds, tid);
        stage_x(0, u, wid, lane, lds); if (!xf32) stage_x(1, u, wid, lane, lds);
        f32x4 g1[2][2];
#pragma unroll
        for (int bj = 0; bj < 2; ++bj)
#pragma unroll
            for (int n = 0; n < 2; ++n) { const int c = col0 + bj * HALF + 4 * n; g1[bj][n] = *(const f32x4*)(res_gate + (size_t)bt * 12288 + c) * *(const f32x4*)(res_gain + c); }
        ex1.collect(u, lds, tid);
        residual_half(0, acc, part, g1, u, wr, wc, fr, fq, lds);
        if (xf32) { asm volatile("s_waitcnt lgkmcnt(0)" ::: "memory"); __builtin_amdgcn_s_barrier(); stage_x(1, u, wid, lane, lds); asm volatile("s_waitcnt vmcnt(0)" ::: "memory"); __builtin_amdgcn_s_barrier(); asm volatile("" ::: "memory"); }
        residual_half(1, acc, part, g1, u, wr, wc, fr, fq, lds);
        if (hout) {
            ex2.publish(part, u, wr, wc, fr, fq, lds, tid);
            f32x4 na[2][2], nb[2][2];
#pragma unroll
            for (int bj = 0; bj < 2; ++bj)
#pragma unroll
                for (int n = 0; n < 2; ++n) { const int c = col0 + bj * HALF + 4 * n; na[bj][n] = *(const f32x4*)(nx_gain + c) * (*(const f32x4*)(nx_scale + (size_t)bt * 12288 + c) + 1.0f); nb[bj][n] = *(const f32x4*)(nx_shift + (size_t)bt * 12288 + c); }
            ex2.collect(u, lds, tid);
            const float qinv = 1.0f / hs[bt];
#pragma unroll
            for (int ai = 0; ai < 2; ++ai)
#pragma unroll
                for (int m = 0; m < 4; ++m) { const int rl = ai * HALF + wr * 64 + m * 16 + fr; const float r = S[rl]; const size_t grow = (size_t)u.pm * BM + rl;
#pragma unroll
                    for (int bj = 0; bj < 2; ++bj) { const f32x4 h0 = ((acc[ai][bj][m][0] * r) * na[bj][0] + nb[bj][0]) * qinv, h1 = ((acc[ai][bj][m][1] * r) * na[bj][1] + nb[bj][1]) * qinv;
                        u32x2 w; w.x = pk4_i8(h0.x, h0.y, h0.z, h0.w); w.y = pk4_i8(h1.x, h1.y, h1.z, h1.w);
                        *(u32x2*)((unsigned char*)hout + grow * DM + col0 + bj * HALF) = w; } }
        }
    }
};
}

#define XB_TMO      128
#define XB_XCNT(j)  (256  + 64 * (j))
#define XB_XSUB(j)  (1280 + 64 * (j))
#define XB_XGEN(j)  (2304 + 64 * (j))
#define XB_TOP      3328
#define XB_TOPGEN   3392
#define XCD_BAR_WORDS 3456
#define XB_SPIN_CAP (1u << 18)
__device__ __forceinline__ unsigned xb_ld(unsigned* p)              { return __hip_atomic_load(p, __ATOMIC_RELAXED, __HIP_MEMORY_SCOPE_AGENT); }
__device__ __forceinline__ unsigned xb_add(unsigned* p, unsigned v) { return __hip_atomic_fetch_add(p, v, __ATOMIC_RELAXED, __HIP_MEMORY_SCOPE_AGENT); }
__device__ __forceinline__ unsigned xb_xcc_id() { return (unsigned)__builtin_amdgcn_s_getreg((3 << 11) | 20) & 0xFu; }
#define XB_SPIN(cond, bar) do { unsigned _sp = 0; while (cond) { __builtin_amdgcn_s_sleep(1); \
    if ((++_sp & 255u) == 0u) { if (xb_ld(&(bar)[XB_TMO])) break; if (_sp > XB_SPIN_CAP) { atomicAdd(&(bar)[XB_TMO], 1u); break; } } } } while (0)
struct XcdBarrier { unsigned* bar; unsigned x; volatile LAS unsigned* st; int wave; };
__device__ __forceinline__ XcdBarrier xcd_barrier_post(unsigned* bar, volatile LAS unsigned* st, int wave) {
    XcdBarrier b; b.bar = bar; b.x = xb_xcc_id(); b.st = st; b.wave = wave;
    if (wave == 0 && lane_id_fresh() == 0) (void)xb_add(&bar[XB_XCNT(b.x)], 1u);
    return b;
}
__device__ __forceinline__ void xcd_barrier_complete(unsigned* bar, unsigned x, unsigned& nloc, unsigned& nx) {
    const unsigned G = gridDim.x * gridDim.y * gridDim.z;
    unsigned sum, cnt, mine, sp = 0u;
    for (;;) {
        sum = 0u; cnt = 0u; mine = 0u;
#pragma unroll
        for (unsigned j = 0; j < 16; ++j) { const unsigned c = xb_ld(&bar[XB_XCNT(j)]); sum += c; cnt += (c > 0u) ? 1u : 0u; mine = (j == x) ? c : mine; }
        if (sum == G) break;
        __builtin_amdgcn_s_sleep(1);
        if ((++sp & 255u) == 0u) { if (xb_ld(&bar[XB_TMO])) break; if (sp > XB_SPIN_CAP) { atomicAdd(&bar[XB_TMO], 1u); break; } }
    }
    nloc = mine > 0u ? mine : 1u; nx = cnt > 0u ? cnt : 1u;
}
__device__ __forceinline__ void xcd_barrier(const XcdBarrier& b) {
    asm volatile("s_waitcnt vmcnt(0)" ::: "memory");
    __syncthreads();
    if (b.wave == 0 && lane_id_fresh() == 0) {
        unsigned* bar = b.bar; asm volatile("" : "+s"(bar));
        __builtin_amdgcn_s_waitcnt(0);
        unsigned nloc = b.st[0], nx = b.st[1];
        if (nloc == 0u) { xcd_barrier_complete(bar, b.x, nloc, nx); b.st[0] = nloc; b.st[1] = nx; }
        const unsigned old = xb_add(&bar[XB_XSUB(b.x)], 1u);
        const unsigned gen = old / nloc;
        if (old + 1u == (gen + 1u) * nloc) {
            __builtin_amdgcn_fence(__ATOMIC_RELEASE, "agent");
            asm volatile("s_waitcnt vmcnt(0)" ::: "memory");
            const unsigned og = xb_add(&bar[XB_TOP], 1u);
            const unsigned tg = og / nx;
            if (og + 1u == (tg + 1u) * nx) xb_add(&bar[XB_TOPGEN], 1u);
            else XB_SPIN(xb_ld(&bar[XB_TOPGEN]) == tg, bar);
            __builtin_amdgcn_fence(__ATOMIC_ACQUIRE, "agent");
            xb_add(&bar[XB_XGEN(b.x)], 1u);
            asm volatile("s_waitcnt vmcnt(0)" ::: "memory");
        } else {
            XB_SPIN(xb_ld(&bar[XB_XGEN(b.x)]) == gen, bar);
            __builtin_amdgcn_fence(__ATOMIC_ACQUIRE, "agent");
            asm volatile("s_waitcnt vmcnt(0)" ::: "memory");
        }
    }
    __syncthreads();
}

struct Args {
    const float *x, *c, *rel_bias, *w_mod, *b_mod, *mix_pre, *mix_post, *w_in, *fox_bias, *conv_w, *conv_b, *conv_g, *conv_beta, *sinks,
                *w_br_a, *w_br_b, *w_br_c, *w_br_d, *w_out, *ffn_pre, *ffn_post, *w_gate, *w_up, *w_down;
    float* out; unsigned char* ws; int ph_lo, ph_hi;
};
struct Frame {
    LAS unsigned char* lds; volatile LAS unsigned* MISC; gu32* ctl;
    int wave, G;
    __device__ __forceinline__ int lane_() const { return lane_id_fresh(); }
    __device__ __forceinline__ int tid_() const { return wave * 64 + lane_id_fresh(); }
    unsigned char* ws;
};

__device__ __forceinline__ int t5_bucket(int d) {
    if (d < 16) return d;
    int b = 15;
    b += (d >= 16); b += (d >= 21); b += (d >= 27); b += (d >= 35); b += (d >= 46); b += (d >= 59); b += (d >= 77); b += (d >= 99);
    b += (d >= 128); b += (d >= 166); b += (d >= 216); b += (d >= 280); b += (d >= 363); b += (d >= 470); b += (d >= 609); b += (d >= 790);
    return b;
}

__device__ __forceinline__ void transpose_item(const float* W, int ldw, int n0s, bf16* WT, int K, int drow0, int k0, LAS float* scr, int lane) {
#pragma unroll 8
    for (int i = 0; i < 32; ++i) { const int kk = 2 * i + (lane >> 5); scr[kk * 33 + (lane & 31)] = W[(size_t)(k0 + kk) * ldw + n0s + (lane & 31)]; }
    LDS_WAIT(); asm volatile("" ::: "memory");
    const int c = lane & 7;
#pragma unroll
    for (int j = 0; j < 4; ++j) { const int n = (lane >> 3) + 8 * j; const LAS float* s = scr + (8 * c) * 33 + n;
        u32x4 o; o.x = pk2(s[0 * 33], s[1 * 33]); o.y = pk2(s[2 * 33], s[3 * 33]); o.z = pk2(s[4 * 33], s[5 * 33]); o.w = pk2(s[6 * 33], s[7 * 33]);
        *(GAS u32x4*)(WT + (size_t)(drow0 + n) * K + k0 + 8 * c) = o; }
    LDS_WAIT(); asm volatile("" ::: "memory");
}
__device__ __forceinline__ void transpose_item8(const float* W, int ldw, int n0s, unsigned char* W8, int K, int drow0, int k0, LAS float* scr, int lane) {
#pragma unroll 8
    for (int i = 0; i < 32; ++i) { const int kk = 2 * i + (lane >> 5); scr[kk * 33 + (lane & 31)] = W[(size_t)(k0 + kk) * ldw + n0s + (lane & 31)] * 64.0f; }
    LDS_WAIT(); asm volatile("" ::: "memory");
    const int c = lane & 3;
#pragma unroll
    for (int j = 0; j < 2; ++j) { const int n = (lane >> 2) + 16 * j; const LAS float* s = scr + (16 * c) * 33 + n;
        u32x4 o; o.x = pk4_fp8(s[0 * 33], s[1 * 33], s[2 * 33], s[3 * 33]); o.y = pk4_fp8(s[4 * 33], s[5 * 33], s[6 * 33], s[7 * 33]);
        o.z = pk4_fp8(s[8 * 33], s[9 * 33], s[10 * 33], s[11 * 33]); o.w = pk4_fp8(s[12 * 33], s[13 * 33], s[14 * 33], s[15 * 33]);
        *(GAS u32x4*)(W8 + (size_t)(drow0 + n) * K + k0 + 16 * c) = o; }
    LDS_WAIT(); asm volatile("" ::: "memory");
}
__device__ __forceinline__ void transpose_item_i8(const float* W, int ldw, int n0s, unsigned char* W8, int K, int drow0, int k0, LAS float* scr, int lane, const LAS float* inv) {
#pragma unroll
    for (int i = 0; i < 8; ++i) { const int kk = 8 * i + (lane >> 3); const f32x4 v = *(const f32x4*)(W + (size_t)(k0 + kk) * ldw + n0s + 4 * (lane & 7));
        LAS float* d = scr + kk * 33 + 4 * (lane & 7); d[0] = v.x; d[1] = v.y; d[2] = v.z; d[3] = v.w; }
    LDS_WAIT(); asm volatile("" ::: "memory");
    const int c = lane & 3;
#pragma unroll
    for (int j = 0; j < 2; ++j) { const int n = (lane >> 2) + 16 * j; const LAS float* s = scr + (16 * c) * 33 + n; const float f = inv[n];
        u32x4 o; o.x = pk4_i8(s[0 * 33] * f, s[1 * 33] * f, s[2 * 33] * f, s[3 * 33] * f); o.y = pk4_i8(s[4 * 33] * f, s[5 * 33] * f, s[6 * 33] * f, s[7 * 33] * f);
        o.z = pk4_i8(s[8 * 33] * f, s[9 * 33] * f, s[10 * 33] * f, s[11 * 33] * f); o.w = pk4_i8(s[12 * 33] * f, s[13 * 33] * f, s[14 * 33] * f, s[15 * 33] * f);
        *(GAS u32x4*)(W8 + (size_t)(drow0 + n) * K + k0 + 16 * c) = o; }
    LDS_WAIT(); asm volatile("" ::: "memory");
}
__device__ __forceinline__ int map_in_row(int c) {
    if (c >= 3072 && c < 4096) { const int u = c - 3072; return u < 512 ? 3072 + 256 * (u >> 7) + (u & 127) : 3072 + 256 * ((u - 512) >> 7) + 128 + (u & 127); }
    return c;
}
__device__ __forceinline__ void p0_prologue(Frame& F, const Args& a) {
    {
        LAS float* ca = (LAS float*)F.lds;
        LAS float* red = (LAS float*)(F.lds + 16384);
        for (int i = F.tid_(); i < 2 * DM; i += 512) { const float v = a.c[i]; ca[i] = v * fsigmoid(v); }
        __syncthreads();
        float* MOD = (float*)(F.ws + WS_MOD);
        for (int it = bid_fresh(); it < 2 * 192; it += F.G) {
            const int l = it / 192, n = (it % 192) * 64 + F.lane_();
            const float* w = a.w_mod + (size_t)l * DM * 12288 + n;
            float a0 = 0.f, a1 = 0.f; const int kb = F.wave * 256;
#pragma unroll 8
            for (int k = 0; k < 256; ++k) { const float wv = w[(size_t)(kb + k) * 12288]; a0 += ca[kb + k] * wv; a1 += ca[DM + kb + k] * wv; }
            red[(F.wave * 2 + 0) * 64 + F.lane_()] = a0; red[(F.wave * 2 + 1) * 64 + F.lane_()] = a1;
            __syncthreads();
            if (F.tid_() < 128) { const int b = F.tid_() >> 6; float s = a.b_mod[l * 12288 + n];
#pragma unroll
                for (int w8 = 0; w8 < 8; ++w8) s += red[(w8 * 2 + b) * 64 + F.lane_()];
                MOD[(size_t)(l * 2 + b) * 12288 + n] = s; }
            __syncthreads();
        }
    }
    LAS float* scr = (LAS float*)(F.lds + F.wave * 16384);
    const int gw = bid_fresh() * 8 + F.wave, NGW = F.G * 8;
    constexpr int I_IN = 0, I_BR = 8 * 64, I_OUT = 32 * 64, I_G = 32 * 176, I_D = 88 * 64;
    constexpr int I_LAYER = I_IN + 4 * I_BR + I_OUT + I_D;
    for (int it = gw; it < DEPTH * I_LAYER; it += NGW) {
        const int l = it / I_LAYER; int r = it - l * I_LAYER;
        unsigned char* wl = F.ws + WS_W + (size_t)l * W_LAYER;
        if (r < I_IN) { const int kb = r / 152, nb = r % 152, c = nb * 32;
            transpose_item(a.w_in + (size_t)l * DM * INW, INW, c < 3072 ? c : c + 4, (bf16*)(wl + W_IN), DM, map_in_row(c), kb * 64, scr, F.lane_()); continue; }
        r -= I_IN;
        if (r < 4 * I_BR) { const int z = r / I_BR, q = r % I_BR, kb = q / 64, nb = q % 64;
            const float* src = (z == 0 ? a.w_br_a : z == 1 ? a.w_br_b : z == 2 ? a.w_br_c : a.w_br_d) + (size_t)l * 512 * DM;
            transpose_item(src, DM, nb * 32, (bf16*)(wl + W_BR) + z * 512, DM, nb * 32, kb * 64, scr, F.lane_()); continue; }
        r -= 4 * I_BR;
        if (r < I_OUT) { const int kb = r / 64, nb = r % 64;
            transpose_item(a.w_out + (size_t)l * DM * DM, DM, nb * 32, (bf16*)(wl + W_OUT), DM, nb * 32, kb * 64, scr, F.lane_()); continue; }
        r -= I_OUT;
        { const int kb = r / 64, nb = r % 64;
            transpose_item(a.w_down + (size_t)l * DFF * DM, DM, nb * 32, (bf16*)(wl + W_DN), DFF, nb * 32, kb * 64, scr, F.lane_()); }
    }
    {
        LAS float* cm = (LAS float*)(F.lds + RING_BYTES + 4096);
        LAS float* inv = cm + 256;
        const int lane = F.lane_();
        __syncthreads();
        for (int it = bid_fresh(); it < DEPTH * (2 * 176 + 408); it += F.G) {
            const int l = it / 760, q = it % 760;
            unsigned char* wl = F.ws + WS_W + (size_t)l * W_LAYER;
            const float* src; int ldw; unsigned char* dst; float* sc;
            if (q < 352) { const int up = q / 176, c0 = (q % 176) * 32, drow0 = 256 * (c0 >> 7) + (c0 & 127) + up * 128;
                src = (up ? a.w_up : a.w_gate) + (size_t)l * DM * DFF + c0; ldw = DFF; dst = wl + W_GU + (size_t)drow0 * DM; sc = (float*)(F.ws + WS_SW) + (size_t)l * 2 * DFF + drow0; }
            else { const int c = (q - 352) * 32, drow0 = c < 19 * 256 ? map_in_row(c) : c;
                src = a.w_in + (size_t)l * DM * INW + (c < 3072 ? c : c + 4); ldw = INW; dst = wl + W_IN + (size_t)drow0 * DM; sc = (float*)(F.ws + WS_SG) + (size_t)l * 13056 + drow0; }
            LAS unsigned char* s16 = (LAS unsigned char*)scr;
            f32x4 mx = {0.f, 0.f, 0.f, 0.f};
#pragma unroll 1
            for (int ch = 0; ch < 4; ++ch) { const int k0 = (F.wave * 4 + ch) * 64;
#pragma unroll
                for (int i = 0; i < 8; ++i) { const int kk = 8 * i + (lane >> 3); const f32x4 v = *(const f32x4*)(src + (size_t)(k0 + kk) * ldw + 4 * (lane & 7));
                    mx.x = fmaxf(mx.x, fabsf(v.x)); mx.y = fmaxf(mx.y, fabsf(v.y)); mx.z = fmaxf(mx.z, fabsf(v.z)); mx.w = fmaxf(mx.w, fabsf(v.w));
                    *(LAS u32x2*)(s16 + ch * 4096 + kk * 64 + 8 * (lane & 7)) = (u32x2){cvt_pk_bf16(v.x, v.y), cvt_pk_bf16(v.z, v.w)}; } }
#pragma unroll
            for (int e = 0; e < 4; ++e) { float t = mx[e]; t = fmaxf(t, shx<8>(t)); t = fmaxf(t, shx<16>(t)); t = fmaxf(t, shx<32>(t)); mx[e] = t; }
            if (lane < 8) *(LAS f32x4*)(cm + F.wave * 32 + 4 * lane) = mx;
            __syncthreads();
            { const int t = F.tid_(); if (t < 32) { float m8 = 1e-30f;
#pragma unroll
                for (int w = 0; w < 8; ++w) m8 = fmaxf(m8, cm[w * 32 + t]);
                inv[t] = 127.0f / m8; sc[t] = m8 * (1.0f / 127.0f); } }
            __syncthreads();
            { const int c = lane & 3;
#pragma unroll 1
                for (int ch = 0; ch < 4; ++ch) { const int k0 = (F.wave * 4 + ch) * 64;
#pragma unroll
                    for (int jj = 0; jj < 2; ++jj) { const int n = (lane >> 2) + 16 * jj; const LAS unsigned short* sp = (const LAS unsigned short*)(s16 + ch * 4096 + (16 * c) * 64 + n * 2); const float f = inv[n];
                        float e[16];
#pragma unroll
                        for (int i2 = 0; i2 < 16; ++i2) e[i2] = __builtin_bit_cast(float, (unsigned)sp[i2 * 32] << 16) * f;
                        u32x4 o; o.x = pk4_i8(e[0], e[1], e[2], e[3]); o.y = pk4_i8(e[4], e[5], e[6], e[7]); o.z = pk4_i8(e[8], e[9], e[10], e[11]); o.w = pk4_i8(e[12], e[13], e[14], e[15]);
                        *(GAS u32x4*)(dst + (size_t)n * DM + k0 + 16 * c) = o; } } }
            __syncthreads();
        }
    }
}

__device__ __forceinline__ void h2_scales(Frame& F, const Args& a) {
    LAS float* red = (LAS float*)(F.lds + RING_BYTES + 4096);
    const float* MOD = (const float*)(F.ws + WS_MOD);
    const int t = F.tid_(), lane = t & 63, c = 4 * t;
#pragma unroll
    for (int q = 0; q < 4; ++q) { const int l = q >> 1; const float* modq = MOD + (size_t)q * 12288;
        const f32x4 g = *(const f32x4*)(a.ffn_pre + l * DM + c), sc = *(const f32x4*)(modq + 8192 + c), sf = *(const f32x4*)(modq + 6144 + c);
        const f32x4 na = g * (sc + 1.0f);
        float sm = (na.x * na.x + na.y * na.y) + (na.z * na.z + na.w * na.w), mx = fmaxf(fmaxf(fabsf(sf.x), fabsf(sf.y)), fmaxf(fabsf(sf.z), fabsf(sf.w)));
        sm += shx<1>(sm); sm += shx<2>(sm); sm += shx<4>(sm); sm += shx<8>(sm); sm += shx<16>(sm); sm += shx<32>(sm);
        mx = fmaxf(mx, shx<1>(mx)); mx = fmaxf(mx, shx<2>(mx)); mx = fmaxf(mx, shx<4>(mx)); mx = fmaxf(mx, shx<8>(mx)); mx = fmaxf(mx, shx<16>(mx)); mx = fmaxf(mx, shx<32>(mx));
        if (lane == 0) { red[(q * 8 + F.wave) * 2] = sm; red[(q * 8 + F.wave) * 2 + 1] = mx; } }
    __syncthreads();
    if (t < 4) { float sm = 0.f, mx = 0.f;
#pragma unroll
        for (int w = 0; w < 8; ++w) { sm += red[(t * 8 + w) * 2]; mx = fmaxf(mx, red[(t * 8 + w) * 2 + 1]); }
        ((float*)(F.ws + WS_HS))[t] = (5.5f * sqrtf(sm * (1.0f / DM)) + mx) * (1.0f / 127.0f); }
    __syncthreads();
}

struct NormArgs {
    const float* xin; float* xout; const bf16* yo; bf16* hout; float* lf; unsigned char* h8; float* hr;
    const float* res_gate; const float* res_gain;
    const float* nx_gain; const float* nx_scale; const float* nx_shift;
    const float* wf; const float* fox_b;
    int flags;
};
__device__ __forceinline__ void norm_phase(Frame& F, const NormArgs& n) {
    const bool RES = n.flags & 1, NEXT = n.flags & 2, FG = n.flags & 4;
    const int tid = opaque_v(F.tid_()), lane = tid & 63, wave = __builtin_amdgcn_readfirstlane(tid >> 6);
    LAS f32x4* wfl = (LAS f32x4*)F.lds;
    LAS f32x4* pG1 = (LAS f32x4*)(F.lds + 32768);
    LAS f32x4* pNA = (LAS f32x4*)(F.lds + 40960);
    LAS f32x4* pNB = (LAS f32x4*)(F.lds + 49152);
    const int rows_per = M / (F.G * 8);
    const int b = (bid_fresh() * 8 * rows_per) / SEQ;
    if (FG) {
        for (int s = tid; s < DM; s += 512) { const int l = s & 63, ji = s >> 6, j = ji >> 2, i = ji & 3, c = 256 * j + 4 * l + i;
            wfl[s] = *(const f32x4*)(n.wf + (size_t)c * INW + 3072); }
    }
    { const int s = tid, c = 4 * s;
        if (RES) { const f32x4 g = *(const f32x4*)(n.res_gate + (size_t)b * 12288 + c), w = *(const f32x4*)(n.res_gain + c); pG1[s] = g * w; }
        if (NEXT) { const f32x4 g = *(const f32x4*)(n.nx_gain + c), sc = *(const f32x4*)(n.nx_scale + (size_t)b * 12288 + c); pNA[s] = g * (sc + 1.0f); pNB[s] = *(const f32x4*)(n.nx_shift + (size_t)b * 12288 + c); } }
    __syncthreads();
    const int gw = bid_fresh() * 8 + wave;
    const int row_lo = gw * rows_per;
    float fb[4] = {0.f, 0.f, 0.f, 0.f};
    if (FG) { fb[0] = n.fox_b[0]; fb[1] = n.fox_b[1]; fb[2] = n.fox_b[2]; fb[3] = n.fox_b[3]; }
    const bool XB = n.flags & 8;
    f32x4 nx[8]; u32x2 nxb[8], ny[8];
#define NORM_LOAD(row_) do { const size_t r_ = (size_t)(row_); \
        if (XB) { _Pragma("unroll") for (int j = 0; j < 8; ++j) nxb[j] = *(const u32x2*)((const bf16*)n.xin + r_ * (2 * DM) + DM + 256 * j + 4 * lane); } \
        else { _Pragma("unroll") for (int j = 0; j < 8; ++j) nx[j] = *(const f32x4*)(n.xin + r_ * DM + 256 * j + 4 * lane); } \
        if (RES) { _Pragma("unroll") for (int j = 0; j < 8; ++j) ny[j] = *(const u32x2*)(n.yo + r_ * DM + 256 * j + 4 * lane); } } while (0)
#pragma unroll
    for (int j = 0; j < 8; ++j) { nx[j] = (f32x4){0.f, 0.f, 0.f, 0.f}; nxb[j] = (u32x2){0u, 0u}; ny[j] = (u32x2){0u, 0u}; }
    NORM_LOAD(row_lo);
#pragma unroll 1
    for (int rr = 0; rr < rows_per; ++rr) {
        const size_t row = (size_t)(row_lo + rr);
        f32x4 v[8]; u32x2 y[8];
#pragma unroll
        for (int j = 0; j < 8; ++j) { v[j] = XB ? (f32x4){bf_lo(nxb[j].x), bf_hi(nxb[j].x), bf_lo(nxb[j].y), bf_hi(nxb[j].y)} : nx[j]; y[j] = ny[j]; }
        if (rr + 1 < rows_per) NORM_LOAD(row + 1);
        if (RES) {
            float ss = 0.f;
#pragma unroll
            for (int j = 0; j < 8; ++j) {
                const float y0 = bf_lo(y[j].x), y1 = bf_hi(y[j].x), y2 = bf_lo(y[j].y), y3 = bf_hi(y[j].y); ss += (y0 * y0 + y1 * y1) + (y2 * y2 + y3 * y3); }
            const float r = 1.0f / sqrtf(wave_sum(ss) * (1.0f / DM) + RMS_EPS);
#pragma unroll
            for (int j = 0; j < 8; ++j) { const f32x4 yy = (f32x4){bf_lo(y[j].x), bf_hi(y[j].x), bf_lo(y[j].y), bf_hi(y[j].y)};
                v[j] = v[j] + pG1[64 * j + lane] * (yy * r);
                if (n.flags & 16) { u32x2 w; w.x = cvt_pk_bf16(v[j].x, v[j].y); w.y = cvt_pk_bf16(v[j].z, v[j].w); *(u32x2*)((bf16*)n.xout + row * (2 * DM) + DM + 256 * j + 4 * lane) = w;
                    v[j] = (f32x4){bf_lo(w.x), bf_hi(w.x), bf_lo(w.y), bf_hi(w.y)}; }
                else *(f32x4*)(n.xout + row * DM + 256 * j + 4 * lane) = v[j]; }
        }
        if (NEXT) {
            float ss = 0.f;
#pragma unroll
            for (int j = 0; j < 8; ++j) ss += (v[j].x * v[j].x + v[j].y * v[j].y) + (v[j].z * v[j].z + v[j].w * v[j].w);
            const float r = 1.0f / sqrtf(wave_sum(ss) * (1.0f / DM) + RMS_EPS);
            float f0 = 0.f, f1 = 0.f, f2 = 0.f, f3 = 0.f, hmx = 1e-30f;
#pragma unroll
            for (int j = 0; j < 8; ++j) { const f32x4 h = (v[j] * r) * pNA[64 * j + lane] + pNB[64 * j + lane];
                if (n.hout) { u32x2 w; w.x = pk2(h.x, h.y); w.y = pk2(h.z, h.w); *(u32x2*)(n.hout + row * DM + 256 * j + 4 * lane) = w; }
                if (n.h8) { v[j] = h; hmx = fmaxf(hmx, fmaxf(fmaxf(fabsf(h.x), fabsf(h.y)), fmaxf(fabsf(h.z), fabsf(h.w)))); }
                if (FG) { const f32x4 w0 = wfl[(j * 4 + 0) * 64 + lane], w1 = wfl[(j * 4 + 1) * 64 + lane], w2 = wfl[(j * 4 + 2) * 64 + lane], w3 = wfl[(j * 4 + 3) * 64 + lane];
                    f0 += h.x * w0.x + h.y * w1.x + h.z * w2.x + h.w * w3.x; f1 += h.x * w0.y + h.y * w1.y + h.z * w2.y + h.w * w3.y;
                    f2 += h.x * w0.z + h.y * w1.z + h.z * w2.z + h.w * w3.z; f3 += h.x * w0.w + h.y * w1.w + h.z * w2.w + h.w * w3.w; }
                asm volatile("" ::: "memory"); }
            if (n.h8) {
                hmx = fmaxf(hmx, shx<1>(hmx)); hmx = fmaxf(hmx, shx<2>(hmx)); hmx = fmaxf(hmx, shx<4>(hmx)); hmx = fmaxf(hmx, shx<8>(hmx)); hmx = fmaxf(hmx, shx<16>(hmx)); hmx = fmaxf(hmx, shx<32>(hmx));
                const float qi = 127.0f / hmx;
                if (lane == 0) n.hr[row] = hmx * (1.0f / 127.0f);
#pragma unroll
                for (int j = 0; j < 8; ++j) *(unsigned*)(n.h8 + row * (2 * DM) + 256 * j + 4 * lane) = pk4_i8(v[j].x * qi, v[j].y * qi, v[j].z * qi, v[j].w * qi); }
            if (FG) { f0 = wave_sum(f0); f1 = wave_sum(f1); f2 = wave_sum(f2); f3 = wave_sum(f3);
                if (lane == 0) { float z[4] = {f0 + fb[0], f1 + fb[1], f2 + fb[2], f3 + fb[3]}; f32x4 o;
#pragma unroll
                    for (int k = 0; k < 4; ++k) { const float t = z[k]; o[k] = fminf(t, 0.f) - log1pf(expf(-fabsf(t))); }
                    *(f32x4*)(n.lf + row * 4) = o; } }
        }
    }
#undef NORM_LOAD
    __syncthreads();
}
__device__ __forceinline__ void fox_scan(Frame& F, int bh) {
    const int tid = opaque_v(F.tid_()), lane = tid & 63, wave = __builtin_amdgcn_readfirstlane(tid >> 6);
    const int b = bh >> 2, hd = bh & 3; const float* lf = (const float*)(F.ws + WS_LF); float* kb = (float*)(F.ws + WS_KB) + (size_t)bh * SEQ;
    LAS float* wtot = (LAS float*)(F.lds + RING_BYTES + 64);
    float v[16]; float run = 0.f;
#pragma unroll
    for (int k = 0; k < 16; ++k) { run += lf[((size_t)b * SEQ + tid * 16 + k) * 4 + hd]; v[k] = run; }
    float inc = run;

    { float t; t = shup<1>(inc, lane); if (lane >= 1) inc += t; t = shup<2>(inc, lane); if (lane >= 2) inc += t; t = shup<4>(inc, lane); if (lane >= 4) inc += t; t = shup<8>(inc, lane); if (lane >= 8) inc += t; t = shup<16>(inc, lane); if (lane >= 16) inc += t; t = shup<32>(inc, lane); if (lane >= 32) inc += t; }
    if (lane == 63) wtot[wave] = inc;
    __syncthreads();
    float off = inc - run;
    for (int w = 0; w < wave; ++w) off += wtot[w];
#pragma unroll
    for (int k = 0; k < 16; ++k) kb[tid * 16 + k] = -(v[k] + off) * LOG2E;
    __syncthreads();
}

namespace att {
#define KSWZ(row, colB) ((row) * 256 + ((colB) ^ (((row) & 7) << 4)))
#define KSWZ64(row, colB) ((row) * 128 + ((colB) ^ (((row) & 7) << 4)))
#define SBAR() __builtin_amdgcn_sched_barrier(0)
__device__ __forceinline__ int crow(int r, int hi) { return (r & 3) + 8 * (r >> 2) + 4 * hi; }
template <int NC> __device__ __forceinline__ int v_st(int k, int c) { const int kk = (k & ~0xC) | ((k & 4) << 1) | ((k & 8) >> 1); return ((kk >> 3) * NC + (c >> 5)) * 512 + ((kk & 7) * 32 + (c & 31)) * 2; }
__device__ __forceinline__ int v_rd_base(int lane) { return ((lane & 3) << 3) | (((lane >> 2) & 3) << 6) | (((lane >> 4) & 1) << 5) | (((lane >> 5) & 1) << 8); }

__device__ __forceinline__ void softmax_tile(f32x16& p0, f32x16& p1, float& m_reg, float& l_reg, float& alpha, bf16x8& pa0, bf16x8& pa1, bf16x8& pa2, bf16x8& pa3) {
    float pmax = p0[0];
#pragma unroll
    for (int r = 1; r < 16; ++r) pmax = fmaxf(pmax, p0[r]);
#pragma unroll
    for (int r = 0; r < 16; ++r) pmax = fmaxf(pmax, p1[r]);
    { auto rr = __builtin_amdgcn_permlane32_swap(__float_as_uint(pmax), __float_as_uint(pmax), false, false);
      pmax = fmaxf(__uint_as_float(rr[0]), __uint_as_float(rr[1])); }
    const float mn = fmaxf(m_reg, pmax);
    alpha = __builtin_amdgcn_exp2f(m_reg - mn); m_reg = mn;
    float ps = 0.f;
#pragma unroll
    for (int r = 0; r < 16; ++r) { p0[r] = __builtin_amdgcn_exp2f(p0[r] - mn); ps += p0[r]; }
#pragma unroll
    for (int r = 0; r < 16; ++r) { p1[r] = __builtin_amdgcn_exp2f(p1[r] - mn); ps += p1[r]; }
    { auto rr = __builtin_amdgcn_permlane32_swap(__float_as_uint(ps), __float_as_uint(ps), false, false);
      ps = __uint_as_float(rr[0]) + __uint_as_float(rr[1]); }
    l_reg = l_reg * alpha + ps;
#define PK4(P, B_, OUT) do { unsigned a0 = cvt_pk_bf16(P[B_+0], P[B_+1]), a1 = cvt_pk_bf16(P[B_+2], P[B_+3]);                          \
        unsigned b0 = cvt_pk_bf16(P[B_+4], P[B_+5]), b1 = cvt_pk_bf16(P[B_+6], P[B_+7]);                                             \
        auto r0 = __builtin_amdgcn_permlane32_swap(a0, b0, false, false); auto r1 = __builtin_amdgcn_permlane32_swap(a1, b1, false, false); \
        u32x4 w = {r0[0], r1[0], r0[1], r1[1]}; OUT = __builtin_bit_cast(bf16x8, w); } while (0)
    PK4(p0, 0, pa0); PK4(p0, 8, pa1); PK4(p1, 0, pa2); PK4(p1, 8, pa3);
#undef PK4
}
__device__ __forceinline__ void qkt128(f32x16& p0, f32x16& p1, LAS const char* Kt, int r32, int hi, const bf16x8* qr) {
    LAS const char* kb[4];
#pragma unroll
    for (int dd = 0; dd < 4; ++dd) kb[dd] = Kt + KSWZ(r32, (dd * 16 + hi * 8) * 2);
#pragma unroll
    for (int d0 = 0; d0 < 8; ++d0) { LAS const char* a = kb[d0 & 3] + (d0 >> 2) * 128;
        const bf16x8 b0 = *(LAS const bf16x8*)a, b1 = *(LAS const bf16x8*)(a + 32 * 256);
        p0 = __builtin_amdgcn_mfma_f32_32x32x16_bf16(b0, qr[d0], p0, 0, 0, 0);
        p1 = __builtin_amdgcn_mfma_f32_32x32x16_bf16(b1, qr[d0], p1, 0, 0, 0); }
}
__device__ __forceinline__ void qkt64(f32x16& p0, f32x16& p1, LAS const char* Kt, int r32, int hi, const bf16x8* qr) {
#pragma unroll
    for (int d0 = 0; d0 < 4; ++d0) { LAS const char* a = Kt + KSWZ64(r32, (d0 * 16 + hi * 8) * 2);
        const bf16x8 b0 = *(LAS const bf16x8*)a, b1 = *(LAS const bf16x8*)(a + 32 * 128);
        p0 = __builtin_amdgcn_mfma_f32_32x32x16_bf16(b0, qr[d0], p0, 0, 0, 0);
        p1 = __builtin_amdgcn_mfma_f32_32x32x16_bf16(b1, qr[d0], p1, 0, 0, 0); }
}
template <int ND0>
__device__ __forceinline__ void pv_tile(f32x16* o, int vb, bf16x8 pa0, bf16x8 pa1, bf16x8 pa2, bf16x8 pa3) {
    constexpr int KS = ND0 * 1024, HF = ND0 * 512;
#define TRRD(dst, off) asm volatile("ds_read_b64_tr_b16 %0, %1 offset:%2" : "=&v"(dst) : "v"(vb), "i"(off) : "memory")
#define PV_D0(d0) do { s16x4 l0, l1, l2, l3, h0, h1, h2, h3; constexpr int b_ = (d0) * 512; \
        TRRD(l0, b_); TRRD(h0, b_ + HF); TRRD(l1, b_ + KS); TRRD(h1, b_ + KS + HF); TRRD(l2, b_ + 2 * KS); TRRD(h2, b_ + 2 * KS + HF); TRRD(l3, b_ + 3 * KS); TRRD(h3, b_ + 3 * KS + HF); \
        asm volatile("s_waitcnt lgkmcnt(0)" ::: "memory"); SBAR(); \
        o[d0] = __builtin_amdgcn_mfma_f32_32x32x16_bf16(pa0, (bf16x8){l0[0], l0[1], l0[2], l0[3], h0[0], h0[1], h0[2], h0[3]}, o[d0], 0, 0, 0); \
        o[d0] = __builtin_amdgcn_mfma_f32_32x32x16_bf16(pa1, (bf16x8){l1[0], l1[1], l1[2], l1[3], h1[0], h1[1], h1[2], h1[3]}, o[d0], 0, 0, 0); \
        o[d0] = __builtin_amdgcn_mfma_f32_32x32x16_bf16(pa2, (bf16x8){l2[0], l2[1], l2[2], l2[3], h2[0], h2[1], h2[2], h2[3]}, o[d0], 0, 0, 0); \
        o[d0] = __builtin_amdgcn_mfma_f32_32x32x16_bf16(pa3, (bf16x8){l3[0], l3[1], l3[2], l3[3], h3[0], h3[1], h3[2], h3[3]}, o[d0], 0, 0, 0); } while (0)
    PV_D0(0); PV_D0(1);
    if constexpr (ND0 == 4) { PV_D0(2); PV_D0(3); }
#undef PV_D0
#undef TRRD
}
template <int ND0>
__device__ __forceinline__ void store_o(const f32x16* o, float l_reg, LAS float* li_l, bf16* Ow, int r32, int hi) {
    if (hi == 0) li_l[r32] = l_reg;
    LDS_WAIT();
    float rli[16];
#pragma unroll
    for (int r = 0; r < 16; ++r) rli[r] = __builtin_amdgcn_rcpf(li_l[crow(r, hi)]);
#pragma unroll
    for (int r = 0; r < 16; ++r) { const int orow = crow(r, hi);
#pragma unroll
        for (int d0 = 0; d0 < ND0; ++d0) { const float v = o[d0][r] * rli[r]; const float vn = shx<1>(v);
            if ((r32 & 1) == 0) *(unsigned*)(Ow + (size_t)orow * DM + d0 * 32 + r32) = cvt_pk_bf16(v, vn); } }
}
#define RESC(ND0) do { if (__any(alpha < 1.f)) { if (hi == 0) al_l[r32] = alpha; LDS_WAIT(); \
        _Pragma("unroll") for (int d_ = 0; d_ < (ND0); ++d_) _Pragma("unroll") for (int r = 0; r < 16; ++r) o[d_][r] *= al_l[crow(r, hi)]; } } while (0)

constexpr int A_V = 0, A_K = 32768, A_WS = 65536, A_KB = 67584, A_LUT = 68096, A_MISC = 74752;

template <int KIND>
__device__ __forceinline__ void attn128_unit(Frame& F, const Args& a, int l, int b, int h, int qb) {
    const int tid = opaque_v(F.tid_()), wid = __builtin_amdgcn_readfirstlane(tid >> 6), lane = tid & 63, r32 = lane & 31, hi = lane >> 5;
    LAS char* lds = (LAS char*)F.lds;
    LAS char* V_lds = lds + A_V; LAS char* K_lds = lds + A_K;
    LAS float* wsf = (LAS float*)(lds + A_WS) + wid * 64; LAS float* li_l = wsf; LAS float* al_l = wsf + 32;
    LAS float* kbuf = (LAS float*)(lds + A_KB);
    LAS float* lut = (LAS float*)(lds + A_LUT);
    LAS unsigned* bw = (LAS unsigned*)(lds + A_MISC);
    const bf16* PJ = (const bf16*)(F.ws + WS_PJ);
    const int q0 = qb * 256, qlo = q0 + wid * 32, qpos = qlo + r32;
    const size_t rowb = (size_t)b * SEQ;
    const bf16* Qp = PJ + (rowb + qpos) * LDP + (KIND == 0 ? PJ_BQ : PJ_AQ) + h * 128;
    const bf16* Kp = PJ + rowb * LDP + (KIND == 0 ? PJ_BK : PJ_AK) + h * 128;
    const bf16* Vp = PJ + rowb * LDP + (KIND == 0 ? PJ_BV : PJ_AV) + h * 128;
    const float* kbg = (const float*)(F.ws + WS_KB) + (size_t)(b * 4 + h) * SEQ;
    bf16x8 qr[8];
#pragma unroll
    for (int d0 = 0; d0 < 8; ++d0) qr[d0] = *(const bf16x8*)(Qp + d0 * 16 + hi * 8);
    const int sr = tid >> 4, sc = (tid & 15) * 8, vst0 = v_st<4>(sr, sc), vst1 = v_st<4>(32 + sr, sc), kws = KSWZ(sr, sc * 2);
    const int vb0 = (int)(unsigned)(size_t)V_lds + v_rd_base(lane);
    unsigned selmask = 0u; unsigned blkmask = 0u; float c31 = 0.f;
    if constexpr (KIND == 1) {
        const int own = qb;
        for (int i = tid; i < 1408; i += 512) { const int d = i - 128; lut[i] = d < 0 ? -__builtin_inff() : a.rel_bias[t5_bucket(d) * 12 + h] * LOG2E; }
        c31 = a.rel_bias[31 * 12 + h] * LOG2E;
        if (own > 0) {
            const float* km = (const float*)(F.ws + WS_CTL + CTL_KMEAN) + (size_t)l * 64 * 512 + (size_t)(b * 32 + sr) * 512 + h * 128 + sc;
            const f32x4 m0 = *(const f32x4*)km * (1.0f / 256.0f), m1 = *(const f32x4*)(km + 4) * (1.0f / 256.0f);
            u32x4 wh, wl; float e[8] = {m0.x, m0.y, m0.z, m0.w, m1.x, m1.y, m1.z, m1.w}; unsigned hh[8], ll[8];
#pragma unroll
            for (int k = 0; k < 8; ++k) { hh[k] = f2bf(e[k]); ll[k] = f2bf(e[k] - __builtin_bit_cast(float, hh[k] << 16)); }
            wh = (u32x4){hh[0] | (hh[1] << 16), hh[2] | (hh[3] << 16), hh[4] | (hh[5] << 16), hh[6] | (hh[7] << 16)};
            wl = (u32x4){ll[0] | (ll[1] << 16), ll[2] | (ll[3] << 16), ll[4] | (ll[5] << 16), ll[6] | (ll[7] << 16)};
            *(LAS u32x4*)(K_lds + kws) = wh; *(LAS u32x4*)(K_lds + kws + 32 * 256) = wl;
            __syncthreads();
            f32x16 s0 = {}, s1 = {};
            qkt128(s0, s1, K_lds, r32, hi, qr);
            float v1 = -__builtin_inff(), v2 = v1, v3 = v1; int i1 = 0, i2 = 0, i3 = 0;
#define INS(x, j) do { const float x_ = (x); const int j_ = (j); if (x_ > v1) { v3 = v2; i3 = i2; v2 = v1; i2 = i1; v1 = x_; i1 = j_; } else if (x_ > v2) { v3 = v2; i3 = i2; v2 = x_; i2 = j_; } else if (x_ > v3) { v3 = x_; i3 = j_; } } while (0)
#pragma unroll
            for (int r = 0; r < 16; ++r) { const int j = crow(r, hi); const float x = (j < own) ? (s0[r] + s1[r]) : -__builtin_inff(); INS(x, j); }
            const float w1 = shx<32>(v1), w2 = shx<32>(v2), w3 = shx<32>(v3);
            const int j1 = shx<32>(i1), j2 = shx<32>(i2), j3 = shx<32>(i3);
            INS(w1, j1); INS(w2, j2); INS(w3, j3);
#undef INS
            if (v1 > -__builtin_inff()) selmask |= 1u << i1;
            if (v2 > -__builtin_inff()) selmask |= 1u << i2;
            if (v3 > -__builtin_inff()) selmask |= 1u << i3;
            unsigned um = selmask;

            { um |= shx<1>(um); um |= shx<2>(um); um |= shx<4>(um); um |= shx<8>(um); um |= shx<16>(um); um |= shx<32>(um); }
            if (lane == 0) bw[wid] = um;
            __syncthreads();
            um = 0u;
#pragma unroll
            for (int w = 0; w < 8; ++w) um |= bw[w];
            blkmask = (unsigned)__builtin_amdgcn_readfirstlane((int)um);
        } else { __syncthreads(); }
        selmask |= 1u << own; blkmask |= 1u << own;
    }
    float m_reg = -1e30f, l_reg = 0.f, alpha; f32x16 o[4] = {};
    bf16x8 st_k0, st_k1, st_v0, st_v1; float st_kb = 0.f;
    float rowbound = 0.f; LAS unsigned* vote = bw + 16;
    if constexpr (KIND == 0) {
        float qq = 0.f;
#pragma unroll
        for (int d0 = 0; d0 < 8; ++d0) { const u32x4 w = __builtin_bit_cast(u32x4, qr[d0]);
            qq += (bf_lo(w.x) * bf_lo(w.x) + bf_hi(w.x) * bf_hi(w.x)) + (bf_lo(w.y) * bf_lo(w.y) + bf_hi(w.y) * bf_hi(w.y)) + (bf_lo(w.z) * bf_lo(w.z) + bf_hi(w.z) * bf_hi(w.z)) + (bf_lo(w.w) * bf_lo(w.w) + bf_hi(w.w) * bf_hi(w.w)); }
        qq += shx<32>(qq);
        const float kn2v = __uint_as_float(__hip_atomic_load((const unsigned*)(F.ws + WS_CTL) + CW_KN2 + (l * 8 + b * 4 + h) * 64, RLX_AGENT));
        rowbound = sqrtf(qq) * (2.0f * sqrtf(kn2v)) * 1.02f;
    }
#define LOADT(k0_) do { const bf16* kp_ = Kp + (size_t)((k0_) + sr) * LDP + sc; const bf16* vp_ = Vp + (size_t)((k0_) + sr) * LDP + sc; \
        st_k0 = *(const bf16x8*)kp_; st_k1 = *(const bf16x8*)(kp_ + (size_t)32 * LDP); st_v0 = *(const bf16x8*)vp_; st_v1 = *(const bf16x8*)(vp_ + (size_t)32 * LDP); \
        if (KIND == 0 && tid < 64) st_kb = kbg[(k0_) + tid]; } while (0)
#define WRITET(bf_) do { *(LAS bf16x8*)(K_lds + (bf_) * 16384 + kws) = st_k0; *(LAS bf16x8*)(K_lds + (bf_) * 16384 + kws + 32 * 256) = st_k1; \
        *(LAS bf16x8*)(V_lds + (bf_) * 16384 + vst0) = st_v0; *(LAS bf16x8*)(V_lds + (bf_) * 16384 + vst1) = st_v1; \
        if (KIND == 0 && tid < 64) kbuf[(bf_) * 64 + tid] = st_kb; } while (0)
    int k0; unsigned rem = 0u;
    if constexpr (KIND == 0) { k0 = q0 + 192; }
    else { rem = blkmask; const int jb = __builtin_ctz(rem); rem &= rem - 1u; k0 = jb * 256; }
    int buf = 0;
    LOADT(k0); WRITET(0);
    __syncthreads();
    for (;;) {
        int kn;
        if constexpr (KIND == 0) { kn = k0 - 64; }
        else { if ((k0 & 255) != 192) kn = k0 + 64; else if (rem) { const int jb = __builtin_ctz(rem); rem &= rem - 1u; kn = jb * 256; } else kn = -1; }
        if (kn >= 0) LOADT(kn);
        float kbprev = 0.f; if (KIND == 0 && k0 > 0) kbprev = kbg[k0 - 1];
        bool act = (k0 <= qlo + 31);
        bool sel = true;
        if constexpr (KIND == 1) { sel = (selmask >> (k0 >> 8)) & 1u; act = act && __any(sel); }
        if (act) {
            f32x16 p0, p1;
            if constexpr (KIND == 0) {
                LAS const float* kb_ = kbuf + buf * 64 + 4 * hi;
#pragma unroll
                for (int g = 0; g < 4; ++g) { const f32x4 x0 = *(LAS const f32x4*)(kb_ + 8 * g), x1 = *(LAS const f32x4*)(kb_ + 32 + 8 * g);
                    p0[4 * g] = x0.x; p0[4 * g + 1] = x0.y; p0[4 * g + 2] = x0.z; p0[4 * g + 3] = x0.w; p1[4 * g] = x1.x; p1[4 * g + 1] = x1.y; p1[4 * g + 2] = x1.z; p1[4 * g + 3] = x1.w; }
                if (k0 + 63 > qlo) {
                    const int dq = qpos - k0 - 4 * hi;
#pragma unroll
                    for (int r = 0; r < 16; ++r) { const int c = (r & 3) + 8 * (r >> 2); if (dq - c < 0) p0[r] = -__builtin_inff(); if (dq - c - 32 < 0) p1[r] = -__builtin_inff(); }
                }
            } else {
                const float NEG = -__builtin_inff();
                if (q0 - (k0 + 63) >= 790) {
                    const float v = sel ? c31 : NEG;
#pragma unroll
                    for (int r = 0; r < 16; ++r) { p0[r] = v; p1[r] = v; }
                } else {
                    LAS const float* lp = lut + 128 + (qpos - k0 - 4 * hi) - 63;
#pragma unroll
                    for (int r = 0; r < 16; ++r) { const int c = (r & 3) + 8 * (r >> 2); const float x0 = lp[63 - c], x1 = lp[31 - c]; p0[r] = sel ? x0 : NEG; p1[r] = sel ? x1 : NEG; }
                }
            }
            qkt128(p0, p1, K_lds + buf * 16384, r32, hi, qr);
            bf16x8 pa0, pa1, pa2, pa3;
            softmax_tile(p0, p1, m_reg, l_reg, alpha, pa0, pa1, pa2, pa3);
            RESC(4);
            pv_tile<4>(o, vb0 + buf * 16384, pa0, pa1, pa2, pa3);
        }
        if (kn >= 0) WRITET(buf ^ 1);
        if constexpr (KIND == 0) { const bool done = __all(rowbound + kbprev - m_reg < -40.0f); if (lane == 0) vote[buf * 8 + wid] = done ? 1u : 0u; }
        __syncthreads();
        if (kn < 0) break;
        if constexpr (KIND == 0) { unsigned v = 1u;
#pragma unroll
            for (int w = 0; w < 8; ++w) v &= vote[buf * 8 + w];
            if (__builtin_amdgcn_readfirstlane((int)v)) break; }
        k0 = kn; buf ^= 1;
    }
#undef LOADT
#undef WRITET
    bf16* Ow = (bf16*)(F.ws + WS_BR) + (rowb + qlo) * DM + (KIND == 0 ? 512 : 0) + h * 128 + 0;
    store_o<4>(o, l_reg, li_l, Ow, r32, hi);
    __syncthreads();
}

constexpr int M_LUT = 131584, M_BINS = 137216, M_SEL = 145408, M_CNT = 146432, M_TASK = 146560, M_NT = 146816, M_ML = 146832, M_WS = 155024;
static_assert(M_WS + 8 * 256 <= LDS_BYTES, "MoBA LDS map");
__device__ __forceinline__ void moba_unit(Frame& F, const Args& a, int l, int b, int h, int own) {
    const int tid = opaque_v(F.tid_()), wid = __builtin_amdgcn_readfirstlane(tid >> 6), lane = tid & 63, r32 = lane & 31, hi = lane >> 5;
    LAS char* lds = (LAS char*)F.lds;
    LAS float* lut = (LAS float*)(lds + M_LUT);
    LAS unsigned char* bins = (LAS unsigned char*)(lds + M_BINS);
    LAS unsigned* selw = (LAS unsigned*)(lds + M_SEL);
    LAS unsigned* cnt = (LAS unsigned*)(lds + M_CNT);
    LAS unsigned short* tasks = (LAS unsigned short*)(lds + M_TASK);
    LAS unsigned* ntp = (LAS unsigned*)(lds + M_NT);
    LAS f32x2* ml = (LAS f32x2*)(lds + M_ML);
    LAS float* al_l = (LAS float*)(lds + M_WS) + wid * 64; LAS int* qix = (LAS int*)(al_l + 32);
    LAS char* vreg = lds + wid * 16384;
    const bf16* PJ = (const bf16*)(F.ws + WS_PJ);
    const int q0 = own * 256; const size_t rowb = (size_t)b * SEQ;
    const bf16* Qb = PJ + (rowb + q0) * LDP + PJ_AQ + h * 128;
    const bf16* KFb = (const bf16*)(F.ws + WS_KF) + (size_t)(b * 4 + h) * 256 * 8 * 2 * 32 * 8;
    const bf16* VFb = (const bf16*)(F.ws + WS_VF) + (size_t)(b * 4 + h) * 512 * 4 * 2 * 32 * 8;
    bf16* part = (bf16*)(F.ws + WS_HY) + (size_t)bid_fresh() * (4 * 256 * 128);
    for (int i = tid; i < 1408; i += 512) { const int d = i - 128; lut[i] = d < 0 ? -__builtin_inff() : a.rel_bias[t5_bucket(d) * 12 + h] * LOG2E; }
    unsigned selmask = 0u;
    if (own > 0) {
        const int sr = tid >> 4, sc = (tid & 15) * 8, kws = KSWZ(sr, sc * 2);
        const float* km = (const float*)(F.ws + WS_CTL + CTL_KMEAN) + (size_t)l * 64 * 512 + (size_t)(b * 32 + sr) * 512 + h * 128 + sc;
        const f32x4 m0 = *(const f32x4*)km * (1.0f / 256.0f), m1 = *(const f32x4*)(km + 4) * (1.0f / 256.0f);
        float e[8] = {m0.x, m0.y, m0.z, m0.w, m1.x, m1.y, m1.z, m1.w}; unsigned hh[8], ll[8];
#pragma unroll
        for (int k = 0; k < 8; ++k) { hh[k] = f2bf(e[k]); ll[k] = f2bf(e[k] - __builtin_bit_cast(float, hh[k] << 16)); }
        *(LAS u32x4*)(lds + kws) = (u32x4){hh[0] | (hh[1] << 16), hh[2] | (hh[3] << 16), hh[4] | (hh[5] << 16), hh[6] | (hh[7] << 16)};
        *(LAS u32x4*)(lds + kws + 32 * 256) = (u32x4){ll[0] | (ll[1] << 16), ll[2] | (ll[3] << 16), ll[4] | (ll[5] << 16), ll[6] | (ll[7] << 16)};
        bf16x8 qn[8];
#pragma unroll
        for (int d0 = 0; d0 < 8; ++d0) qn[d0] = *(const bf16x8*)(Qb + (size_t)(wid * 32 + r32) * LDP + d0 * 16 + hi * 8);
        __syncthreads();
        f32x16 s0 = {}, s1 = {};
        qkt128(s0, s1, lds, r32, hi, qn);
        float v1 = -__builtin_inff(), v2 = v1, v3 = v1; int i1 = 0, i2 = 0, i3 = 0;
#define INS(x, j) do { const float x_ = (x); const int j_ = (j); if (x_ > v1) { v3 = v2; i3 = i2; v2 = v1; i2 = i1; v1 = x_; i1 = j_; } else if (x_ > v2) { v3 = v2; i3 = i2; v2 = x_; i2 = j_; } else if (x_ > v3) { v3 = x_; i3 = j_; } } while (0)
#pragma unroll
        for (int r = 0; r < 16; ++r) { const int j = crow(r, hi); const float x = (j < own) ? (s0[r] + s1[r]) : -__builtin_inff(); INS(x, j); }
        const float w1 = shx<32>(v1), w2 = shx<32>(v2), w3 = shx<32>(v3);
        const int j1 = shx<32>(i1), j2 = shx<32>(i2), j3 = shx<32>(i3);
        INS(w1, j1); INS(w2, j2); INS(w3, j3);
#undef INS
        if (v1 > -__builtin_inff()) selmask |= 1u << i1;
        if (v2 > -__builtin_inff()) selmask |= 1u << i2;
        if (v3 > -__builtin_inff()) selmask |= 1u << i3;
    }
    if (hi == 0) selw[wid * 32 + r32] = selmask;
    LAS unsigned char* wcnt = (LAS unsigned char*)(lds + M_TASK);
    for (int j = 0; j < own; ++j) { const unsigned long long bal = __ballot(hi == 0 && ((selmask >> j) & 1u)); if (lane == 0) wcnt[wid * 32 + j] = (unsigned char)__builtin_popcountll(bal); }
    __syncthreads();
    if (tid < 32) { unsigned c = 0; for (int w = 0; w < 8; ++w) c += wcnt[w * 32 + tid]; cnt[tid] = tid < own ? c : 0u; }
    for (int j = 0; j < own; ++j) { const bool mine = hi == 0 && ((selmask >> j) & 1u); const unsigned long long bal = __ballot(mine);
        if (mine) { unsigned pos = (unsigned)__builtin_popcountll(bal & ((1ull << lane) - 1ull)); for (int w = 0; w < wid; ++w) pos += wcnt[w * 32 + j]; bins[j * 256 + pos] = (unsigned char)(wid * 32 + r32); } }
    __syncthreads();
    if (tid == 0) { unsigned n = 0; for (int j = 0; j < own; ++j) { const unsigned c = (cnt[j] + 31u) >> 5; for (unsigned k = 0; k < c; ++k) tasks[n++] = (unsigned short)(j | (k << 8)); } ntp[0] = n; }
    __syncthreads();
    const int nt = (int)ntp[0];
    const int vb0 = (int)(unsigned)(size_t)vreg + v_rd_base(lane);
#pragma unroll 1
    for (int k = wid; k < nt + 8; k += 8) {
        int j, qi, slot, ktn; bool valid = true;
        if (k < nt) { const unsigned tk = tasks[k]; j = tk & 255; const int idx = (int)(tk >> 8) * 32 + r32; valid = idx < (int)cnt[j];
            qi = bins[j * 256 + (valid ? idx : 0)]; const unsigned sm = selw[qi]; slot = __builtin_popcount(sm & ((1u << j) - 1u)); ktn = 4; }
        else { const int g = k - nt; j = own; qi = g * 32 + r32; slot = 3; ktn = (g >> 1) + 1; }
        const int t = q0 + qi;
        bf16x8 qr[8];
#pragma unroll
        for (int d0 = 0; d0 < 8; ++d0) qr[d0] = *(const bf16x8*)(Qb + (size_t)qi * LDP + d0 * 16 + hi * 8);
        if (hi == 0) qix[r32] = valid ? (qi | (slot << 8)) : -1;
        float m_reg = -1e30f, l_reg = 0.f, alpha; f32x16 o[4] = {};
        const bf16* kpb = KFb + ((size_t)(j * 8) * 8 * 2 * 32 + hi * 32 + r32) * 8;
        const bf16* vpb = VFb + ((size_t)(j * 16) * 4 * 2 * 32 + hi * 32 + r32) * 8;
#pragma unroll 1
        for (int kt = 0; kt < ktn; ++kt) {
            const int k0 = j * 256 + kt * 64;
            const bf16* kp = kpb + (size_t)(kt * 2) * 8 * 512;
            const bf16* vp = vpb + (size_t)(kt * 4) * 4 * 512;
            bf16x8 kA0[4], kA1[4], kB0[4], kB1[4], vA[8], vB[8];
#pragma unroll
            for (int d = 0; d < 4; ++d) { kA0[d] = *(const bf16x8*)(kp + d * 512); kA1[d] = *(const bf16x8*)(kp + (8 + d) * 512); }
#pragma unroll
            for (int d = 0; d < 4; ++d) { kB0[d] = *(const bf16x8*)(kp + (4 + d) * 512); kB1[d] = *(const bf16x8*)(kp + (12 + d) * 512); }
#pragma unroll
            for (int i = 0; i < 8; ++i) vA[i] = *(const bf16x8*)(vp + i * 512);
            int dq = t - k0 - 4 * hi; dq = dq > 1100 ? 1100 : dq;
            LAS const float* lp = lut + 128 + dq - 63;
            f32x16 p0, p1;
#pragma unroll
            for (int r = 0; r < 16; ++r) { const int c = (r & 3) + 8 * (r >> 2); p0[r] = lp[63 - c]; p1[r] = lp[31 - c]; }
#pragma unroll
            for (int d = 0; d < 4; ++d) { p0 = __builtin_amdgcn_mfma_f32_32x32x16_bf16(kA0[d], qr[d], p0, 0, 0, 0); p1 = __builtin_amdgcn_mfma_f32_32x32x16_bf16(kA1[d], qr[d], p1, 0, 0, 0); }
#pragma unroll
            for (int d = 0; d < 4; ++d) { p0 = __builtin_amdgcn_mfma_f32_32x32x16_bf16(kB0[d], qr[4 + d], p0, 0, 0, 0); p1 = __builtin_amdgcn_mfma_f32_32x32x16_bf16(kB1[d], qr[4 + d], p1, 0, 0, 0); }
            asm volatile("" ::: "memory");
#pragma unroll
            for (int i = 0; i < 8; ++i) vB[i] = *(const bf16x8*)(vp + (8 + i) * 512);
            bf16x8 pa0, pa1, pa2, pa3;
            softmax_tile(p0, p1, m_reg, l_reg, alpha, pa0, pa1, pa2, pa3);
            if (__any(alpha < 1.f)) { if (hi == 0) al_l[r32] = alpha; LDS_WAIT();
#pragma unroll
                for (int d_ = 0; d_ < 4; ++d_)
#pragma unroll
                    for (int r = 0; r < 16; ++r) o[d_][r] *= al_l[crow(r, hi)]; }
#pragma unroll
            for (int d0 = 0; d0 < 4; ++d0) { o[d0] = __builtin_amdgcn_mfma_f32_32x32x16_bf16(pa0, vA[d0], o[d0], 0, 0, 0); o[d0] = __builtin_amdgcn_mfma_f32_32x32x16_bf16(pa1, vA[4 + d0], o[d0], 0, 0, 0); }
#pragma unroll
            for (int d0 = 0; d0 < 4; ++d0) { o[d0] = __builtin_amdgcn_mfma_f32_32x32x16_bf16(pa2, vB[d0], o[d0], 0, 0, 0); o[d0] = __builtin_amdgcn_mfma_f32_32x32x16_bf16(pa3, vB[4 + d0], o[d0], 0, 0, 0); }
        }
        if (hi == 0) { al_l[r32] = l_reg; if (valid) ml[slot * 256 + qi] = (f32x2){m_reg, l_reg}; }
        LDS_WAIT();
#pragma unroll
        for (int r = 0; r < 16; ++r) { const int rr = crow(r, hi); const int qrow = qix[rr]; const float rl = __builtin_amdgcn_rcpf(al_l[rr]);
            bf16* prow = part + ((size_t)(qrow < 0 ? 0 : (qrow >> 8)) * 256 + (qrow < 0 ? 0 : (qrow & 255))) * 128;
#pragma unroll
            for (int d0 = 0; d0 < 4; ++d0) { const float v = o[d0][r] * rl; const float vn = shx<1>(v);
                if ((r32 & 1) == 0 && qrow >= 0) *(unsigned*)(prow + d0 * 32 + r32) = cvt_pk_bf16(v, vn); } }
    }
    VM_WAIT();
    __syncthreads();
    __builtin_amdgcn_fence(__ATOMIC_ACQUIRE, "agent");
    { const int q = tid >> 1, hf = tid & 1; const unsigned sm = selw[q]; const int ns = __builtin_popcount(sm);
        float ms[4], ls[4]; float Mx = -1e30f;
#pragma unroll
        for (int s_ = 0; s_ < 4; ++s_) { const bool on = (s_ == 3) || (s_ < ns); const f32x2 v = on ? ml[s_ * 256 + q] : (f32x2){-1e30f, 0.f}; ms[s_] = v.x; ls[s_] = v.y; Mx = fmaxf(Mx, v.x); }
        float wsum = 0.f, wgt[4];
#pragma unroll
        for (int s_ = 0; s_ < 4; ++s_) { wgt[s_] = ls[s_] * __builtin_amdgcn_exp2f(ms[s_] - Mx); wsum += wgt[s_]; }
        const float rw = 1.0f / wsum;
        float accv[64];
#pragma unroll
        for (int i = 0; i < 64; ++i) accv[i] = 0.f;
#pragma unroll
        for (int s_ = 0; s_ < 4; ++s_) { if (wgt[s_] > 0.f) { const float w = wgt[s_] * rw; const u32x4* src = (const u32x4*)(part + ((size_t)s_ * 256 + q) * 128 + hf * 64);
#pragma unroll
                for (int c8 = 0; c8 < 8; ++c8) { const u32x4 x = src[c8];
                    accv[c8 * 8 + 0] += w * bf_lo(x.x); accv[c8 * 8 + 1] += w * bf_hi(x.x); accv[c8 * 8 + 2] += w * bf_lo(x.y); accv[c8 * 8 + 3] += w * bf_hi(x.y);
                    accv[c8 * 8 + 4] += w * bf_lo(x.z); accv[c8 * 8 + 5] += w * bf_hi(x.z); accv[c8 * 8 + 6] += w * bf_lo(x.w); accv[c8 * 8 + 7] += w * bf_hi(x.w); } } }
        u32x4* dst = (u32x4*)((bf16*)(F.ws + WS_BR) + (rowb + q0 + q) * DM + h * 128 + hf * 64);
#pragma unroll
        for (int c8 = 0; c8 < 8; ++c8) { u32x4 o4; o4.x = cvt_pk_bf16(accv[c8 * 8 + 0], accv[c8 * 8 + 1]); o4.y = cvt_pk_bf16(accv[c8 * 8 + 2], accv[c8 * 8 + 3]);
            o4.z = cvt_pk_bf16(accv[c8 * 8 + 4], accv[c8 * 8 + 5]); o4.w = cvt_pk_bf16(accv[c8 * 8 + 6], accv[c8 * 8 + 7]); dst[c8] = o4; } }
    __syncthreads();
}

__device__ __forceinline__ void swa_unit(Frame& F, const Args& a, int l, int b, int kvh, int nb) {
    const int tid = opaque_v(F.tid_()), wid = __builtin_amdgcn_readfirstlane(tid >> 6), lane = tid & 63, r32 = lane & 31, hi = lane >> 5;
    LAS char* lds = (LAS char*)F.lds;
    LAS char* V_lds = lds + A_V; LAS char* K_lds = lds + A_K;
    LAS float* wsf = (LAS float*)(lds + A_WS) + wid * 64; LAS float* li_l = wsf; LAS float* al_l = wsf + 32;
    LAS float* lut = (LAS float*)(lds + A_LUT);
    const bf16* PJ = (const bf16*)(F.ws + WS_PJ);
    const int T0 = nb * 128; const size_t rowb = (size_t)b * SEQ;
    const int g = wid >> 1, half = wid & 1, head = kvh * 4 + g;
    for (int i = tid; i < 4 * 384; i += 512) { const int gg = i / 384, d = (i % 384) - 128;
        lut[i] = (d < 0 || d >= 128) ? -__builtin_inff() : a.rel_bias[t5_bucket(d) * 12 + 4 + kvh * 4 + gg] * LOG2E; }
    { const int sr = tid >> 3, sc = (tid & 7) * 8;
#pragma unroll
      for (int kt = 0; kt < 4; ++kt) { const int k0 = T0 - 128 + 64 * kt; if (k0 < 0) continue;
          const bf16* kp = PJ + (rowb + k0 + sr) * LDP + PJ_DK + kvh * 64 + sc; const bf16* vp = PJ + (rowb + k0 + sr) * LDP + PJ_DV + kvh * 64 + sc;
          const bf16x8 kk = *(const bf16x8*)kp, vv = *(const bf16x8*)vp;
          *(LAS bf16x8*)(K_lds + kt * 8192 + KSWZ64(sr, sc * 2)) = kk; *(LAS bf16x8*)(V_lds + kt * 8192 + v_st<2>(sr, sc)) = vv; } }
    __syncthreads();
    const float sinkv = a.sinks[l * 8 + head] * LOG2E;
    const int vb0 = (int)(unsigned)(size_t)V_lds + v_rd_base(lane);
#pragma unroll 1
    for (int qg = 0; qg < 2; ++qg) {
        const int r0 = T0 + 64 * half + 32 * qg, qpos = r0 + r32;
        const bf16* Qp = PJ + (rowb + qpos) * LDP + PJ_DQ + head * 64;
        bf16x8 qr[4];
#pragma unroll
        for (int d0 = 0; d0 < 4; ++d0) qr[d0] = *(const bf16x8*)(Qp + d0 * 16 + hi * 8);
        float m_reg = sinkv, l_reg = 1.0f, alpha; f32x16 o[2] = {};
#pragma unroll 1
        for (int kt = 0; kt < 4; ++kt) { const int k0 = T0 - 128 + 64 * kt;
            if (k0 < 0 || k0 > r0 + 31 || k0 + 63 < r0 - 127) continue;
            LAS const float* lp = lut + g * 384 + 128 + (qpos - k0 - 4 * hi) - 63;
            f32x16 p0, p1;
#pragma unroll
            for (int r = 0; r < 16; ++r) { const int c = (r & 3) + 8 * (r >> 2); p0[r] = lp[63 - c]; p1[r] = lp[31 - c]; }
            qkt64(p0, p1, K_lds + kt * 8192, r32, hi, qr);
            bf16x8 pa0, pa1, pa2, pa3;
            softmax_tile(p0, p1, m_reg, l_reg, alpha, pa0, pa1, pa2, pa3);
            RESC(2);
            pv_tile<2>(o, vb0 + kt * 8192, pa0, pa1, pa2, pa3);
        }
        bf16* Ow = (bf16*)(F.ws + WS_BR) + (rowb + r0) * DM + 1536 + head * 64;
        store_o<2>(o, l_reg, li_l, Ow, r32, hi);
    }
    __syncthreads();
}
#undef RESC
}

__device__ __forceinline__ void conv_unit(Frame& F, const Args& a, int l, int cu) {
    const int c = opaque_v(F.tid_()), lane = c & 63, wave = __builtin_amdgcn_readfirstlane(c >> 6); const int m0 = cu * 32, t0 = m0 % SEQ;
    const bf16* PJ = (const bf16*)(F.ws + WS_PJ);
    LAS float* cv = (LAS float*)F.lds;
    float w[31];
#pragma unroll
    for (int j = 0; j < 31; ++j) w[j] = a.conv_w[(size_t)l * 31 * 512 + j * 512 + c];
    const float cb = a.conv_b[l * 512 + c];
    float in[62];
#pragma unroll
    for (int i = 0; i < 62; ++i) { const int t = t0 - 30 + i; in[i] = t >= 0 ? __builtin_bit_cast(float, (unsigned)PJ[(size_t)(m0 - 30 + i) * LDP + PJ_GLU + c] << 16) : 0.f; }
#pragma unroll
    for (int t = 0; t < 32; ++t) { float s = cb;
#pragma unroll
        for (int j = 0; j < 31; ++j) s += w[j] * in[t + j];
        cv[t * 512 + c] = s; }
    __syncthreads();
    const float* lg = a.conv_g + l * 512; const float* lb = a.conv_beta + l * 512;
    bf16* BR = (bf16*)(F.ws + WS_BR);
#pragma unroll 1
    for (int rr = 0; rr < 4; ++rr) { const int t = wave * 4 + rr;
        const f32x4 v0 = *(LAS const f32x4*)(cv + t * 512 + 8 * lane), v1 = *(LAS const f32x4*)(cv + t * 512 + 8 * lane + 4);
        float s = (v0.x + v0.y) + (v0.z + v0.w) + (v1.x + v1.y) + (v1.z + v1.w);
        const float mu = wave_sum(s) * (1.0f / 512.0f);
        const f32x4 d0 = v0 - mu, d1 = v1 - mu;
        float q = (d0.x * d0.x + d0.y * d0.y) + (d0.z * d0.z + d0.w * d0.w) + (d1.x * d1.x + d1.y * d1.y) + (d1.z * d1.z + d1.w * d1.w);
        const float rs = 1.0f / sqrtf(wave_sum(q) * (1.0f / 512.0f) + LN_EPS);
        const f32x4 g0 = *(const f32x4*)(lg + 8 * lane), g1 = *(const f32x4*)(lg + 8 * lane + 4), b0 = *(const f32x4*)(lb + 8 * lane), b1 = *(const f32x4*)(lb + 8 * lane + 4);
        f32x4 y0 = d0 * rs * g0 + b0, y1 = d1 * rs * g1 + b1;
#pragma unroll
        for (int k = 0; k < 4; ++k) { y0[k] = y0[k] * fsigmoid(y0[k]); y1[k] = y1[k] * fsigmoid(y1[k]); }
        u32x4 o; o.x = pk2(y0.x, y0.y); o.y = pk2(y0.z, y0.w); o.z = pk2(y1.x, y1.y); o.w = pk2(y1.z, y1.w);
        *(u32x4*)(BR + (size_t)(m0 + t) * DM + 1024 + 8 * lane) = o; }
    __syncthreads();
}

constexpr int NU_ATTQ = 64, NU_SWA = 256, NU_CONV = 512, NU_REST = NU_SWA + NU_CONV;
__device__ __forceinline__ void mixer_phase(Frame& F, const Args& a, int l) {
    gu32* heads = F.ctl + CW_QUEUE + 64 * 16 * l;
    LAS unsigned* slot = (LAS unsigned*)(F.lds + RING_BYTES + 128);
    const int x = (int)(xb_xcc_id() & 7u);
    for (int s = 0; s < 8; ++s) {
        const int qq = (x + s) & 7;
        for (;;) {
            if (F.tid_() == 0) slot[0] = __hip_atomic_fetch_add(heads + 64 * qq, 1u, RLX_AGENT);
            __syncthreads();
            const int idx = (int)slot[0];
            __syncthreads();
            if (idx >= NU_ATTQ) break;
            const int qb = 31 - (idx >> 1), kind = idx & 1;
            if (kind == 1) { if (PH_EN(9)) att::moba_unit(F, a, l, qq >> 2, qq & 3, qb); } else { if (PH_EN(8)) att::attn128_unit<0>(F, a, l, qq >> 2, qq & 3, qb); }
        }
    }
    for (;;) {
        if (F.tid_() == 0) slot[0] = __hip_atomic_fetch_add(heads + 64 * 8, 1u, RLX_AGENT);
        __syncthreads();
        const int idx = (int)slot[0];
        __syncthreads();
        if (idx >= NU_REST) break;
        if (idx < NU_SWA) { if (PH_EN(10)) att::swa_unit(F, a, l, idx >> 7, (idx >> 6) & 1, idx & 63); }
        else { if (PH_EN(11)) conv_unit(F, a, l, idx - NU_SWA); }
    }
}

constexpr int NPHASE = 1 + 8 * DEPTH + 1;
__global__ void __launch_bounds__(512, 2) fwd(Args args) {
    extern __shared__ __attribute__((aligned(16))) unsigned char lds_raw[];
    Frame F;
    F.lds = (LAS unsigned char*)lds_raw; F.MISC = (volatile LAS unsigned*)(F.lds + MISC_OFF);
    F.wave = __builtin_amdgcn_readfirstlane((int)threadIdx.x >> 6); F.G = gridDim.x;
    F.ws = args.ws; F.ctl = (gu32*)(args.ws + WS_CTL);
    for (int u = F.tid_(); u < (LDS_BYTES - RING_BYTES) / 4; u += 512) ((LAS unsigned*)(F.lds + RING_BYTES))[u] = 0u;
    __syncthreads();
    XcdBarrier bar; bar.bar = (unsigned*)(F.ctl + CW_BAR); bar.x = 0; bar.st = nullptr; bar.wave = F.wave;
    const bool one_launch = (args.ph_hi - args.ph_lo) > 1;
    if (one_launch) bar = xcd_barrier_post((unsigned*)(F.ctl + CW_BAR), F.MISC + 8, F.wave);
    const int lo = args.ph_lo, hi = args.ph_hi;
#define IN(k) (lo <= (k) && (k) < hi)
#define SEAM(k) do { if (IN(k) && IN((k) + 1)) xcd_barrier(bar); } while (0)
    float* MOD = (float*)(args.ws + WS_MOD);
    bf16* HY = (bf16*)(args.ws + WS_HY); bf16* PJb = (bf16*)(args.ws + WS_PJ); bf16* GT = (bf16*)(args.ws + WS_GT);
    bf16* BR = (bf16*)(args.ws + WS_BR); bf16* YO = BR; bf16* MID = GT;

#ifdef DBG_STOP
    if (lo >= 100) {
        const int code = lo - 100; const bf16* src; int pitch;
        if (code == 0) { src = HY; pitch = DM; } else if (code == 1) { src = PJb; pitch = LDP; } else if (code == 2) { src = GT; pitch = 8192; } else if (code == 3) { src = BR; pitch = DM; }
        else if (code == 4) { src = MID; pitch = DFF; } else if (code == 5) { src = PJb + 2304; pitch = LDP; } else if (code == 6) { src = GT + 6144; pitch = 8192; } else { src = MID + 3584; pitch = DFF; }
        for (size_t i = (size_t)bid_fresh() * 512 + F.tid_(); i < (size_t)M * DM; i += (size_t)F.G * 512) { const size_t r = i / DM, c = i % DM; args.out[i] = __builtin_bit_cast(float, (unsigned)src[r * pitch + c] << 16); }
        return;
    }
#endif
    if (PH_EN(0) && IN(0)) { p0_prologue(F, args); } SEAM(0);

#pragma unroll 1
    for (int l = 0; l < DEPTH; ++l) {
        const int pb = 1 + 8 * l;
        unsigned char* wl = args.ws + WS_W + (size_t)l * W_LAYER;
        const float* modl = MOD + (size_t)l * 2 * 12288;
        if (l == 0) {
            if (PH_EN(1) && IN(pb)) { if (bid_fresh() == 0) h2_scales(F, args);
                NormArgs n{}; n.xin = args.x; n.hout = nullptr; n.lf = (float*)(args.ws + WS_LF);
                n.nx_gain = args.mix_pre; n.nx_scale = modl + 2048; n.nx_shift = modl; n.wf = args.w_in; n.fox_b = args.fox_bias; n.flags = 2 | 4; n.h8 = (unsigned char*)YO; n.hr = (float*)(args.ws + WS_HR);
                norm_phase(F, n); }
        }
        SEAM(pb);
        if (PH_EN(2) && IN(pb + 1)) {
            if (bid_fresh() >= 192 && bid_fresh() < 200) fox_scan(F, bid_fresh() - 192);
#ifdef DBG_FILL
            { const u32x4* src = (const u32x4*)(HY + (size_t)bid_fresh() * 64 * DM); u32x4* dst = (u32x4*)(BR + (size_t)bid_fresh() * 64 * DM);
              for (int i = F.tid_(); i < 64 * DM / 8; i += 512) dst[i] = src[i]; }
#endif
            { typedef pg8::Dims<DM, DM / 2, DM / 2, 64, 19, 1, 0, 0> D;
              pg8::Gemm g{(const bf16*)YO, (const bf16*)(wl + W_IN)};
              pg8::TileOrder<D> S{F.G, (int)bid_fresh()};
              pg8::EpiProj E{PJb, GT, (bf16*)(args.ws + WS_KF), (bf16*)(args.ws + WS_VF), (float*)(args.ws + WS_CTL + CTL_KMEAN) + (size_t)l * 64 * 512, (unsigned*)(args.ws + WS_CTL) + CW_KN2 + l * 8 * 64,
                               (const float*)(args.ws + WS_HR), (const float*)(args.ws + WS_SG) + (size_t)l * 13056};
              pg8::gemm_phase<D>(F.lds, g, S, E, F.wave); }
            __syncthreads();
            { typedef pg8::Dims<DM, DM / 2, DM / 2, 64, 32, 1, 0, 0> D;
              pg8::Gemm g{(const bf16*)YO, (const bf16*)(wl + W_IN + (size_t)(19 * 256) * DM)};
              pg8::TileOrder<D> S{F.G, (int)bid_fresh()};
              pg8::EpiGate8 E{GT, (const float*)(args.ws + WS_HR), (const float*)(args.ws + WS_SG) + (size_t)l * 13056 + 19 * 256};
              pg8::gemm_phase<D>(F.lds, g, S, E, F.wave); }
        }
        SEAM(pb + 1);
        if (PH_EN(3) && IN(pb + 2)) mixer_phase(F, args, l);
        SEAM(pb + 2);
        if (PH_EN(4) && IN(pb + 3)) {
            typedef pg8::Dims<DM, DM, DM, 64, 8, 1, 0, 0> D;
            pg8::Gemm g{BR, (const bf16*)(wl + W_BR)};
            pg8::TileOrder<D> S{F.G, (int)bid_fresh()};
            pg8::EpiMerge E{(const unsigned char*)GT, HY};
            pg8::gemm_phase<D>(F.lds, g, S, E, F.wave);
        }
        SEAM(pb + 3);
        if (PH_EN(5) && IN(pb + 4)) {
            typedef pg8::Dims<DM, DM, DM, 64, 8, 1, 0, 0> D;
            pg8::Gemm g{HY, (const bf16*)(wl + W_OUT)};
            float* xs = (float*)(args.ws + WS_XS); gu32* xc = F.ctl + (CTL_XCNT / 4);
            pg8::EpiResNorm E{};
            if (l == 0) { E.xf32 = args.x; E.xo = (bf16*)args.out; E.xo_pitch = 2 * DM; E.xo_off = DM; }
            else { E.xb = (const bf16*)args.out; E.xb_pitch = 2 * DM; E.xb_off = DM; E.xo = YO; E.xo_pitch = DM; E.xo_off = 0; }
            E.res_gate = modl + 4096; E.res_gain = args.mix_post + l * DM;
            E.hout = PJb; E.nx_gain = args.ffn_pre + l * DM; E.nx_scale = modl + 8192; E.nx_shift = modl + 6144; E.hs = (const float*)(args.ws + WS_HS) + l * 2;
            E.ex1 = pg8::RowX{xs + (size_t)(l * 4 + 0) * 64 * 256 * 8, xc + (l * 4 + 0) * 64 * 16, F.ctl + 2};
            E.ex2 = pg8::RowX{xs + (size_t)(l * 4 + 1) * 64 * 256 * 8, xc + (l * 4 + 1) * 64 * 16, F.ctl + 2};
#pragma unroll 1
            for (int sl = 0; sl < 2; ++sl) { pg8::SliceOrder<D> S{sl, (int)bid_fresh()}; pg8::gemm_phase<D>(F.lds, g, S, E, F.wave); __syncthreads(); }
        }
        SEAM(pb + 4);
        if (PH_EN(6) && IN(pb + 6)) {
            typedef pg8::Dims<DM / 2, DM / 2, DM / 2, 64, 44, 1, 0, 0> D;
            pg8::Gemm g{PJb, (const bf16*)(wl + W_GU)};
            pg8::TileOrder<D> S{F.G, (int)bid_fresh()};
            pg8::EpiSwiGLU E{MID, DFF, (const float*)(args.ws + WS_SW) + (size_t)l * 2 * DFF, (const float*)(args.ws + WS_HS) + l * 2};
            pg8::gemm_phase<D>(F.lds, g, S, E, F.wave);
        }
        SEAM(pb + 6);
        if (PH_EN(7) && IN(pb + 7)) {
            typedef pg8::Dims<64, DFF, DFF, 64, 8, 1, 0, 0, 32768, (long)DFF * 256 * 2> D;
            pg8::Gemm g{MID, (const bf16*)(wl + W_DN)};
            if (l + 1 < DEPTH) {
                pg8::TileOrder<D> S{F.G, (int)bid_fresh()};
                pg8::EpiBf16 E{YO, DM};
                pg8::gemm_phase<D>(F.lds, g, S, E, F.wave);
            } else {
                float* xs = (float*)(args.ws + WS_XS); gu32* xc = F.ctl + (CTL_XCNT / 4);
                pg8::EpiResNorm E{};
                E.xb = YO; E.xb_pitch = DM; E.xb_off = 0; E.outf = args.out;
                E.res_gate = modl + 10240; E.res_gain = args.ffn_post + l * DM;
                E.ex1 = pg8::RowX{xs + (size_t)(l * 4 + 2) * 64 * 256 * 8, xc + (l * 4 + 2) * 64 * 16, F.ctl + 2};
#pragma unroll 1
                for (int sl = 0; sl < 2; ++sl) { pg8::SliceOrder<D> S{sl, (int)bid_fresh()}; pg8::gemm_phase<D>(F.lds, g, S, E, F.wave); __syncthreads(); }
            }
        }
        if (l + 1 < DEPTH) {
        SEAM(pb + 7);
        if (PH_EN(1) && IN(pb + 8)) { NormArgs n{}; n.xin = args.out; n.xout = args.out; n.yo = YO; n.hout = nullptr; n.lf = (float*)(args.ws + WS_LF);
            n.res_gate = modl + 10240; n.res_gain = args.ffn_post + l * DM;
            const float* modn = MOD + (size_t)(l + 1) * 2 * 12288;
            n.nx_gain = args.mix_pre + (l + 1) * DM; n.nx_scale = modn + 2048; n.nx_shift = modn; n.wf = args.w_in + (size_t)(l + 1) * DM * INW; n.fox_b = args.fox_bias + (l + 1) * 4; n.flags = 1 | 2 | 4 | 8 | 16; n.h8 = (unsigned char*)YO; n.hr = (float*)(args.ws + WS_HR);
            norm_phase(F, n); }
        }
    }
#undef IN
#undef SEAM
}

extern "C" void kernel_launch(void* const* d_in, const int* in_sizes, int n_in, void* d_out, int out_size, void* d_ws, size_t ws_size, hipStream_t stream) {
    static int grid = 0;
    if (grid == 0) {
        if (n_in != 24 || in_sizes[0] != M * DM || out_size != M * DM || ws_size < WS_END) {
            fprintf(stderr, "kernel_launch: unexpected shapes (n_in %d, in0 %d, out %d, ws %zu < %zu?)\n", n_in, n_in > 0 ? in_sizes[0] : -1, out_size, ws_size, (size_t)WS_END); grid = -1; return; }
        int dev = 0, cus = 0, per_cu = 0;
        if (hipGetDevice(&dev) != hipSuccess || hipDeviceGetAttribute(&cus, hipDeviceAttributeMultiprocessorCount, dev) != hipSuccess) { grid = -1; return; }
        if (hipFuncSetAttribute((const void*)fwd, hipFuncAttributeMaxDynamicSharedMemorySize, LDS_BYTES) != hipSuccess) { fprintf(stderr, "kernel_launch: hipFuncSetAttribute failed\n"); grid = -1; return; }
        if (hipOccupancyMaxActiveBlocksPerMultiprocessor(&per_cu, (const void*)fwd, 512, LDS_BYTES) != hipSuccess || per_cu < 1) { fprintf(stderr, "kernel_launch: occupancy query says %d\n", per_cu); }
        (void)hipGetLastError();
        grid = cus;
        if (grid != 256) { fprintf(stderr, "kernel_launch: the fused epilogues assume 256 CUs, found %d\n", grid); grid = -1; return; }
    }
    if (grid < 0) return;
    if (hipMemsetAsync((char*)d_ws + WS_CTL, 0, CTL_ZERO_BYTES, stream) != hipSuccess) return;
    Args a{};
    const float** ap = (const float**)&a;
    for (int i = 0; i < 24; ++i) ap[i] = (const float*)d_in[i];
    a.out = (float*)d_out; a.ws = (unsigned char*)d_ws;
#if defined(DBG_STOP)
    for (int p = 0; p <= DBG_STOP; ++p) { a.ph_lo = p; a.ph_hi = p + 1; hipLaunchKernelGGL(fwd, dim3(grid), dim3(512), LDS_BYTES, stream, a); }
    a.ph_lo = 100 + DBG_SRC; a.ph_hi = 101 + DBG_SRC; hipLaunchKernelGGL(fwd, dim3(grid), dim3(512), LDS_BYTES, stream, a);
#elif MK_PER_PHASE
    for (int p = 0; p < NPHASE; ++p) {
        a.ph_lo = p; a.ph_hi = p + 1;
        hipLaunchKernelGGL(fwd, dim3(grid), dim3(512), LDS_BYTES, stream, a);
    }
#else
    a.ph_lo = 0; a.ph_hi = NPHASE;
    hipLaunchKernelGGL(fwd, dim3(grid), dim3(512), LDS_BYTES, stream, a);
#endif
}
```

```cpp
#include <hip/hip_runtime.h>
#include <cstdio>
#include <cstdint>

#ifndef MK_PER_PHASE
#define MK_PER_PHASE 0
#endif

#ifndef PH_MASK
#define PH_MASK 0xFFFF
#endif
#define PH_EN(k) (((PH_MASK) >> (k)) & 1)
#define GAS __attribute__((address_space(1)))
#define LAS __attribute__((address_space(3)))
typedef unsigned short bf16;
typedef short bf16x8 __attribute__((ext_vector_type(8)));
typedef short s16x4 __attribute__((ext_vector_type(4)));
typedef float f32x4 __attribute__((ext_vector_type(4)));
typedef float f32x2 __attribute__((ext_vector_type(2)));
typedef float f32x16 __attribute__((ext_vector_type(16)));
typedef unsigned u32x4 __attribute__((ext_vector_type(4)));
typedef unsigned u32x2 __attribute__((ext_vector_type(2)));
typedef GAS unsigned gu32;

constexpr int DM = 2048, NBATCH = 2, SEQ = 8192, M = NBATCH * SEQ, DEPTH = 2;
constexpr int DFF = 5632, INW = 13060, INWP = 13056;
constexpr int LDP = 4352;
constexpr int PJ_AQ = 0, PJ_AK = 512, PJ_AV = 1024, PJ_BQ = 1536, PJ_BK = 2048, PJ_BV = 2560, PJ_GLU = 3072, PJ_DQ = 3584, PJ_DK = 4096, PJ_DV = 4224;
constexpr float RMS_EPS = 1e-6f, LN_EPS = 1e-5f, LOG2E = 1.4426950408889634f;
constexpr float C2_128 = 0.08838834764831845f * LOG2E, C2_64 = 0.125f * LOG2E;

constexpr size_t MiB = 1u << 20;
constexpr size_t WS_CTL = 0, CTL_ZERO_BYTES = 1 * MiB;
constexpr size_t WS_MOD = 1 * MiB;
constexpr size_t WS_LF = 1 * MiB + 256 * 1024;
constexpr size_t WS_KB = 1 * MiB + 512 * 1024;
constexpr size_t WS_W = 2 * MiB;
constexpr size_t W_IN = 0, W_BR = 51 * MiB, W_OUT = 59 * MiB, W_GU = 67 * MiB, W_DN = 111 * MiB, W_LAYER = 133 * MiB;
constexpr size_t W_IN8 = W_IN + (size_t)(19 * 256) * DM * 2;
constexpr size_t WS_HY = 268 * MiB;
constexpr size_t WS_PJ = 332 * MiB;
constexpr size_t WS_GT = 468 * MiB;
constexpr size_t WS_BR = 724 * MiB;
constexpr size_t WS_KF = 788 * MiB;
constexpr size_t WS_VF = 804 * MiB;
constexpr size_t WS_XS = 820 * MiB;
constexpr size_t WS_SW = 824 * MiB;
constexpr size_t WS_HS = WS_SW + 96 * 1024;
constexpr size_t WS_HR = WS_SW + 128 * 1024;
constexpr size_t WS_SG = WS_SW + 192 * 1024;
constexpr size_t WS_END = 825 * MiB;
constexpr int CW_BAR = 4096;
constexpr int CW_QUEUE = 8192;
constexpr int CW_KN2 = 12288;
constexpr size_t CTL_XCNT = 128 * 1024;
constexpr size_t CTL_KMEAN = 512 * 1024;

constexpr int RING_BYTES = 131072;
constexpr int MISC_OFF = RING_BYTES + 320;
constexpr int LDS_BYTES = 163840;

#define LDS_WAIT() asm volatile("s_waitcnt lgkmcnt(0)" ::: "memory")
#define VM_WAIT() asm volatile("s_waitcnt vmcnt(0)" ::: "memory")
#define RLX_AGENT __ATOMIC_RELAXED, __HIP_MEMORY_SCOPE_AGENT

typedef __bf16 bf16x2_t __attribute__((ext_vector_type(2)));
__device__ __forceinline__ unsigned cvt_pk_bf16(float lo, float hi) { const f32x2 v = {lo, hi}; const bf16x2_t b = __builtin_convertvector(v, bf16x2_t); return __builtin_bit_cast(unsigned, b); }
__device__ __forceinline__ unsigned f2bf(float f) { unsigned u = __builtin_bit_cast(unsigned, f); return (u + 0x7fffu + ((u >> 16) & 1u)) >> 16; }
__device__ __forceinline__ unsigned pk2(float lo, float hi) { return f2bf(lo) | (f2bf(hi) << 16); }
__device__ __forceinline__ float bf_lo(unsigned w) { return __builtin_bit_cast(float, w << 16); }
__device__ __forceinline__ float bf_hi(unsigned w) { return __builtin_bit_cast(float, w & 0xffff0000u); }
__device__ __forceinline__ float fsigmoid(float x) { return __builtin_amdgcn_rcpf(1.0f + __builtin_amdgcn_exp2f(-x * LOG2E)); }
__device__ __forceinline__ unsigned pk4_i8(float a, float b, float c, float d) {
    const int ia = (int)__builtin_rintf(__builtin_fminf(__builtin_fmaxf(a, -127.f), 127.f)), ib = (int)__builtin_rintf(__builtin_fminf(__builtin_fmaxf(b, -127.f), 127.f));
    const int ic = (int)__builtin_rintf(__builtin_fminf(__builtin_fmaxf(c, -127.f), 127.f)), id = (int)__builtin_rintf(__builtin_fminf(__builtin_fmaxf(d, -127.f), 127.f));
    return (unsigned)(ia & 255) | ((unsigned)(ib & 255) << 8) | ((unsigned)(ic & 255) << 16) | ((unsigned)id << 24);
}
__device__ __forceinline__ unsigned pk4_fp8(float a, float b, float c, float d) { int w = 0; w = __builtin_amdgcn_cvt_pk_fp8_f32(a, b, w, false); w = __builtin_amdgcn_cvt_pk_fp8_f32(c, d, w, true); return (unsigned)w; }
__device__ __forceinline__ int opaque_v(int v) { asm volatile("" : "+v"(v)); return v; }
__device__ __forceinline__ int lane_id_fresh() { int l; asm volatile("v_mbcnt_lo_u32_b32 %0, -1, 0\n\tv_mbcnt_hi_u32_b32 %0, -1, %0" : "=v"(l)); return l; }
template <int M> __device__ __forceinline__ int shx(int v) {
    if constexpr (M < 32) return __builtin_amdgcn_ds_swizzle(v, (M << 10) | 0x1f);
    else return __builtin_amdgcn_ds_bpermute((lane_id_fresh() ^ M) << 2, v);
}
template <int M> __device__ __forceinline__ float shx(float v) { return __builtin_bit_cast(float, shx<M>(__builtin_bit_cast(int, v))); }
template <int M> __device__ __forceinline__ unsigned shx(unsigned v) { return (unsigned)shx<M>((int)v); }
template <int O> __device__ __forceinline__ float shup(float v, int lane) { return __builtin_bit_cast(float, __builtin_amdgcn_ds_bpermute((lane - O) << 2, __builtin_bit_cast(int, v))); }
__device__ __forceinline__ unsigned bid_fresh() { unsigned v = blockIdx.x; asm volatile("" : "+s"(v)); return v; }
__device__ __forceinline__ float wave_sum(float v) {
    v += shx<1>(v); v += shx<2>(v); v += shx<4>(v); v += shx<8>(v); v += shx<16>(v); v += shx<32>(v);
    return v;
}

namespace pg8 {
typedef unsigned short bf16_t;
constexpr int BM = 256, BK = 64, HALF = 128, HTB = HALF * BK * 2, STAGE_BYTES = 8 * HTB, NXCD = 8, WGM = 8;
__host__ __device__ __forceinline__ int lds_byte(int r, int c) { const int st = (r >> 4) * 2 + (c >> 5), rr = r & 15, cc = c & 31, ob = rr * 64 + cc * 2; return st * 1024 + (ob ^ (((ob >> 9) & 1) << 5)); }
__host__ __device__ __forceinline__ void stage_rc(int b, int& R, int& C) { const int st = b / 1024, sb = b % 1024, swz = sb ^ (((sb >> 9) & 1) << 5); R = (st >> 1) * 16 + swz / 64; C = (st & 1) * 32 + (swz % 64) / 2; }
__host__ __device__ __forceinline__ int perm32(int rho) { const int n = rho >> 4, i = rho & 15; return 8 * (i >> 2) + 4 * n + (i & 3); }

struct Unit { int pm, pn, z; };
struct Gemm { const bf16_t* A; const bf16_t* Bt; };
template <int LDA_, int LDB_, int K_, int NM_, int NN_, int Z_, int AZ_, int BZ_, int KSA_ = 128, long APANEL_ = 0> struct Dims { static constexpr int LDA = LDA_, LDB = LDB_, K = K_, NM = NM_, NN = NN_, Z = Z_, AZ = AZ_, BZ = BZ_, KSA = KSA_; static constexpr long APANEL = APANEL_ ? APANEL_ : (long)256 * LDA_ * 2; };

__device__ __forceinline__ void tile_of(int L, int nM, int nN, int& pm, int& pn) {
    const int nwg = nM * nN; int wgid = L;
    { const int q = nwg / NXCD, r = nwg % NXCD, xcd = wgid % NXCD, off = wgid / NXCD; wgid = (xcd < r ? xcd * (q + 1) : r * (q + 1) + (xcd - r) * q) + off; }
    const int nig = WGM * nN, gid = wgid / nig, fm = gid * WGM, gsz = (nM - fm) < WGM ? (nM - fm) : WGM;
    pm = fm + ((wgid % nig) % gsz); pn = (wgid % nig) / gsz;
}
template <class D> struct TileOrder {
    int G, c;
    __device__ __forceinline__ bool next(int i, Unit& u) const {
        const int j = i / D::Z; const int L = j * G + c; if (L >= D::NM * D::NN) return false;
        tile_of(L, D::NM, D::NN, u.pm, u.pn); u.z = i - j * D::Z; return true;
    }
    __device__ __forceinline__ size_t a_off(const Unit& u) const { return (size_t)u.pm * (size_t)D::APANEL + (size_t)u.z * D::AZ; }
    __device__ __forceinline__ size_t b_off(const Unit& u) const { return (size_t)u.pn * ((size_t)256 * D::LDB * 2) + (size_t)u.z * D::BZ; }
};

typedef int i32x4v __attribute__((ext_vector_type(4)));
template <class E, class = void> struct epi_i8 : std::false_type {};
template <class E> struct epi_i8<E, std::void_t<decltype(E::I8)>> : std::bool_constant<E::I8> {};
typedef int i32x8v __attribute__((ext_vector_type(8)));
__device__ __forceinline__ i32x8v cat8(const bf16x8& lo, const bf16x8& hi) { const i32x4v a = __builtin_bit_cast(i32x4v, lo), b = __builtin_bit_cast(i32x4v, hi); return __builtin_shufflevector(a, b, 0, 1, 2, 3, 4, 5, 6, 7); }
template <class D, class Epi, class Sched>
__device__ __forceinline__ void gemm_phase(LAS unsigned char* lds, const Gemm g, const Sched& S, const Epi& E, const int wid) {
    const int lane = lane_id_fresh(), tid = wid * 64 + lane, wr = wid >> 2, wc = wid & 3, fr = lane & 15, fq = lane >> 4;
    constexpr int nt = D::K / BK;
    unsigned voffA[2], voffB[2];
#pragma unroll
    for (int i = 0; i < 2; ++i) { int R, C; stage_rc(tid * 16 + i * 8192, R, C); const int Rb = Epi::PERM ? ((R & ~31) + perm32(R & 31)) : R;
        voffA[i] = (unsigned)(R * D::LDA + C) * 2u; voffB[i] = (unsigned)(Rb * D::LDB + C) * 2u; }
    constexpr size_t kstep = (size_t)(BK * 2), kstepA = (size_t)D::KSA;
    constexpr size_t hstepA = (size_t)HALF * D::LDA * 2, hstepB = (size_t)HALF * D::LDB * 2;
    const unsigned ldsw = (unsigned)wid * 1024u;
    const unsigned ldsb = __builtin_amdgcn_readfirstlane((unsigned)(size_t)lds + ldsw);
    const int aoff = lds_byte(wr * 64 + fr, fq * 8), boff = lds_byte(wc * 32 + fr, fq * 8);
#define PG8_SA(b, h) (((b) * 2 + (h)) * HTB)
#define PG8_SB(b, h) ((4 + (b) * 2 + (h)) * HTB)
#define PG8_STAGE(bufoff, gbase, voff) do { _Pragma("unroll") for (int _i = 0; _i < 2; ++_i) { \
        if constexpr (Epi::F8 || epi_i8<Epi>::value) asm volatile("s_mov_b32 m0, %0\n\ts_nop 0\n\tglobal_load_lds_dwordx4 %1, %2" :: "s"(ldsb + (unsigned)((bufoff) + _i * 8192)), "v"((voff)[_i]), "s"((const char*)(gbase)) : "memory", "m0");   \
        else __builtin_amdgcn_global_load_lds((const unsigned*)((const char*)(gbase) + (voff)[_i]), (LAS unsigned*)(lds + (bufoff) + ldsw + _i * 8192), 16, 0, 0); } } while (0)
#define PG8_LDA(dst, b, h) do { _Pragma("unroll") for (int m = 0; m < 4; ++m) _Pragma("unroll") for (int k = 0; k < 2; ++k) dst[m][k] = *(const LAS bf16x8*)(lds + PG8_SA(b, h) + aoff + m * 2048 + k * 1024); } while (0)
#define PG8_LDB(dst, b, h) do { _Pragma("unroll") for (int n = 0; n < 2; ++n) _Pragma("unroll") for (int k = 0; k < 2; ++k) dst[n][k] = *(const LAS bf16x8*)(lds + PG8_SB(b, h) + boff + n * 2048 + k * 1024); } while (0)
#define PG8_MMA(ai, bj, At, Bt) do { __builtin_amdgcn_s_setprio(1); \
        if constexpr (Epi::F8) { _Pragma("unroll") for (int m = 0; m < 4; ++m) _Pragma("unroll") for (int n = 0; n < 2; ++n) \
            acc[ai][bj][m][n] = __builtin_amdgcn_mfma_scale_f32_16x16x128_f8f6f4(cat8(Bt[n][0], Bt[n][1]), cat8(At[m][0], At[m][1]), acc[ai][bj][m][n], 0, 0, 0, 0, 0, 0); } \
        else if constexpr (epi_i8<Epi>::value) { _Pragma("unroll") for (int m = 0; m < 4; ++m) _Pragma("unroll") for (int n = 0; n < 2; ++n) _Pragma("unroll") for (int k = 0; k < 2; ++k) \
            acc[ai][bj][m][n] = __builtin_bit_cast(f32x4, __builtin_amdgcn_mfma_i32_16x16x64_i8(__builtin_bit_cast(i32x4v, Bt[n][k]), __builtin_bit_cast(i32x4v, At[m][k]), __builtin_bit_cast(i32x4v, acc[ai][bj][m][n]), 0, 0, 0)); } \
        else { _Pragma("unroll") for (int m = 0; m < 4; ++m) _Pragma("unroll") for (int n = 0; n < 2; ++n) _Pragma("unroll") for (int k = 0; k < 2; ++k) \
            acc[ai][bj][m][n] = __builtin_amdgcn_mfma_f32_16x16x32_bf16(Bt[n][k], At[m][k], acc[ai][bj][m][n], 0, 0, 0); } \
        __builtin_amdgcn_s_setprio(0); } while (0)
#define PG8_WAIT_V(n) asm volatile("s_waitcnt vmcnt(" #n ")" ::: "memory")
#define PG8_WAIT_L(n) asm volatile("s_waitcnt lgkmcnt(" #n ")" ::: "memory")
#define PG8_BAR __builtin_amdgcn_s_barrier()
#define PG8_SCHED __builtin_amdgcn_sched_barrier(0)
    Unit cur, nxt; int ui = 0;
    if (!S.next(0, cur)) return;
    f32x4 acc[2][2][4][2];
#pragma unroll
    for (int a = 0; a < 2; ++a)
#pragma unroll
        for (int b = 0; b < 2; ++b)
#pragma unroll
            for (int m = 0; m < 4; ++m)
#pragma unroll
                for (int n = 0; n < 2; ++n) acc[a][b][m][n] = (f32x4){0.f, 0.f, 0.f, 0.f};
    bf16x8 At[4][2], B0[2][2], B1[2][2];
    const char* cA = (const char*)g.A + S.a_off(cur); const char* cB = (const char*)g.Bt + S.b_off(cur);
    PG8_STAGE(PG8_SB(0, 0), cB, voffB); PG8_STAGE(PG8_SB(0, 1), cB + hstepB, voffB); PG8_STAGE(PG8_SA(0, 0), cA, voffA); PG8_STAGE(PG8_SA(0, 1), cA + hstepA, voffA);
    if (wr == 1) PG8_BAR;
    PG8_WAIT_V(2); PG8_BAR;
    PG8_STAGE(PG8_SB(1, 0), cB + kstep, voffB); PG8_STAGE(PG8_SA(1, 0), cA + kstepA, voffA); PG8_STAGE(PG8_SB(1, 1), cB + hstepB + kstep, voffB);
    PG8_WAIT_V(6); PG8_BAR;
    for (;;) {
        const bool has_next = S.next(ui + 1, nxt);
        const char* nA = has_next ? (const char*)g.A + S.a_off(nxt) : cA; const char* nB = has_next ? (const char*)g.Bt + S.b_off(nxt) : cB;
        for (int t = 0; t < nt; t += 2) {
            const bool last = (t == nt - 2);
            const char* a1 = cA + (size_t)(t + 1) * kstepA;
            const char* a2 = last ? nA : cA + (size_t)(t + 2) * kstepA; const char* b2 = last ? nB : cB + (size_t)(t + 2) * kstep;
            const char* a3 = a2 + kstepA; const char* b3 = b2 + kstep;
            PG8_LDB(B0, 0, 0); PG8_LDB(B1, 0, 1); PG8_SCHED; PG8_LDA(At, 0, 0); PG8_STAGE(PG8_SA(1, 1), a1 + hstepA, voffA);
            PG8_WAIT_V(8); PG8_WAIT_L(0); PG8_BAR; PG8_MMA(0, 0, At, B0); PG8_MMA(0, 1, At, B1); PG8_BAR; PG8_SCHED;
            PG8_LDA(At, 0, 1); PG8_STAGE(PG8_SB(0, 0), b2, voffB); PG8_STAGE(PG8_SB(0, 1), b2 + hstepB, voffB); PG8_STAGE(PG8_SA(0, 0), a2, voffA);
            PG8_WAIT_V(8); PG8_WAIT_L(0); PG8_BAR; PG8_MMA(1, 0, At, B0); PG8_MMA(1, 1, At, B1); PG8_BAR; PG8_SCHED;
            PG8_LDB(B0, 1, 0); PG8_LDB(B1, 1, 1); PG8_SCHED; PG8_LDA(At, 1, 0); PG8_STAGE(PG8_SA(0, 1), a2 + hstepA, voffA);
            PG8_WAIT_V(8); PG8_WAIT_L(0); PG8_BAR; PG8_MMA(0, 0, At, B0); PG8_MMA(0, 1, At, B1); PG8_BAR; PG8_SCHED;
            PG8_LDA(At, 1, 1); PG8_STAGE(PG8_SB(1, 0), b3, voffB); PG8_STAGE(PG8_SB(1, 1), b3 + hstepB, voffB); PG8_STAGE(PG8_SA(1, 0), a3, voffA);
            PG8_WAIT_V(8); PG8_WAIT_L(0); PG8_BAR; PG8_MMA(1, 0, At, B0); PG8_MMA(1, 1, At, B1); PG8_BAR; PG8_SCHED;
            if constexpr (Epi::HOOK) { if ((t & 7) == 6 && t != nt - 2) E.mid(acc, cur, t >> 3, wr, wc, fr, fq); }
        }
        if (wr == 0) PG8_BAR;
        if constexpr (!Epi::AFTER_DRAIN) E(acc, cur, wr, wc, fr, fq);
        if (!has_next) break;
#pragma unroll
        for (int a = 0; a < 2; ++a)
#pragma unroll
            for (int b = 0; b < 2; ++b)
#pragma unroll
                for (int m = 0; m < 4; ++m)
#pragma unroll
                    for (int n = 0; n < 2; ++n) acc[a][b][m][n] = (f32x4){0.f, 0.f, 0.f, 0.f};
        cur = nxt; cA = nA; cB = nB; ++ui;
        if (wr == 1) PG8_BAR;
    }
    PG8_WAIT_V(0);
    PG8_BAR;
    if constexpr (Epi::AFTER_DRAIN) E.fused(acc, cur, wr, wc, fr, fq, lds, tid);
#undef PG8_SA
#undef PG8_SB
#undef PG8_STAGE
#undef PG8_LDA
#undef PG8_LDB
#undef PG8_MMA
#undef PG8_WAIT_V
#undef PG8_WAIT_L
#undef PG8_BAR
#undef PG8_SCHED
}

template <bool F8_> struct EpiBf16T {
    static constexpr bool PERM = true, HOOK = false, AFTER_DRAIN = false, F8 = F8_;
    bf16_t* O; int ldc;
    __device__ __forceinline__ void operator()(const f32x4 (&acc)[2][2][4][2], const Unit& u, int wr, int wc, int fr, int fq) const {
        if constexpr (F8_) { const int t = lane_id_fresh(); fr = t & 15; fq = t >> 4; }
        const int row0 = u.pm * BM + wr * 64 + fr, col0 = u.pn * BM + wc * 32 + 8 * fq;
        constexpr float SC = F8_ ? (1.0f / 64.0f) : 1.0f;
#pragma unroll
        for (int ai = 0; ai < 2; ++ai)
#pragma unroll
            for (int m = 0; m < 4; ++m) { bf16_t* rowp = O + (size_t)(row0 + ai * HALF + m * 16) * ldc + col0;
#pragma unroll
                for (int bj = 0; bj < 2; ++bj) { const f32x4 v0 = acc[ai][bj][m][0] * SC, v1 = acc[ai][bj][m][1] * SC;
                    u32x4 w; w.x = cvt_pk_bf16(v0[0], v0[1]); w.y = cvt_pk_bf16(v0[2], v0[3]); w.z = cvt_pk_bf16(v1[0], v1[1]); w.w = cvt_pk_bf16(v1[2], v1[3]);
                    *(u32x4*)(rowp + bj * HALF) = w; } }
    }
};
typedef EpiBf16T<false> EpiBf16;
struct EpiSwiGLU {
    static constexpr bool PERM = true, HOOK = false, AFTER_DRAIN = false, F8 = false, I8 = true;
    bf16_t* O; int ldc; const float* sw; const float* hs;
    __device__ __forceinline__ void operator()(const f32x4 (&acc)[2][2][4][2], const Unit& u, int wr, int wc, int fr, int fq) const {
        const int col0 = u.pn * HALF + wc * 32 + 8 * fq;
        bf16_t* tile = O + (((size_t)u.pm * (ldc / 64) + (col0 >> 6)) * 256 + wr * 64 + fr) * 64 + (col0 & 63);
        const float sh = hs[u.pm >> 5];
        const float* swp = sw + u.pn * BM + wc * 32 + 8 * fq;
        f32x4 sg[2], su[2];
#pragma unroll
        for (int n = 0; n < 2; ++n) { sg[n] = *(const f32x4*)(swp + 4 * n) * sh; su[n] = *(const f32x4*)(swp + HALF + 4 * n) * sh; }
#pragma unroll
        for (int ai = 0; ai < 2; ++ai)
#pragma unroll
            for (int m = 0; m < 4; ++m) { bf16_t* rowp = tile + (size_t)(ai * HALF + m * 16) * 64;
                float o[8];
#pragma unroll
                for (int n = 0; n < 2; ++n)
#pragma unroll
                    for (int j = 0; j < 4; ++j) { const float ag = acc[ai][0][m][n][j], au = acc[ai][1][m][n][j];
                        const float gg = (float)__float_as_int(ag) * sg[n][j], uu = (float)__float_as_int(au) * su[n][j]; o[n * 4 + j] = gg * fsigmoid(gg) * uu; }
                u32x4 w; w.x = cvt_pk_bf16(o[0], o[1]); w.y = cvt_pk_bf16(o[2], o[3]); w.z = cvt_pk_bf16(o[4], o[5]); w.w = cvt_pk_bf16(o[6], o[7]);
                __builtin_nontemporal_store(w, (u32x4*)rowp); }
    }
};
struct EpiProj {
    static constexpr bool PERM = true, HOOK = false, AFTER_DRAIN = false, F8 = false, I8 = true;
    bf16_t* PJ; bf16_t* GT; bf16_t* KF; bf16_t* VF; float* kmean; unsigned* kn2;
    const float* hr; const float* sg;
    __device__ __forceinline__ void operator()(const f32x4 (&acci)[2][2][4][2], const Unit& u, int wr, int wc, int fr, int fq) const {
        const int pn = u.pn, row0 = u.pm * BM + wr * 64 + fr, cw = wc * 32 + 8 * fq;
        f32x4 acc[2][2][4][2];
        { f32x4 cs[2][2]; float rs8[2][4];
#pragma unroll
            for (int bj = 0; bj < 2; ++bj)
#pragma unroll
                for (int n = 0; n < 2; ++n) cs[bj][n] = *(const f32x4*)(sg + pn * BM + bj * HALF + cw + 4 * n);
#pragma unroll
            for (int ai = 0; ai < 2; ++ai)
#pragma unroll
                for (int m = 0; m < 4; ++m) rs8[ai][m] = hr[(size_t)row0 + ai * HALF + m * 16];
#pragma unroll
            for (int ai = 0; ai < 2; ++ai)
#pragma unroll
                for (int bj = 0; bj < 2; ++bj)
#pragma unroll
                    for (int m = 0; m < 4; ++m)
#pragma unroll
                        for (int n = 0; n < 2; ++n)
#pragma unroll
                            for (int j = 0; j < 4; ++j) { const float a = acci[ai][bj][m][n][j]; acc[ai][bj][m][n][j] = (float)__float_as_int(a) * (rs8[ai][m] * cs[bj][n][j]); } }
        if (pn >= 12 && pn < 16) {
            bf16_t* base = PJ + PJ_GLU + (pn - 12) * HALF + cw;
#pragma unroll
            for (int ai = 0; ai < 2; ++ai)
#pragma unroll
                for (int m = 0; m < 4; ++m) { bf16_t* rowp = base + (size_t)(row0 + ai * HALF + m * 16) * LDP;
                    float o[8];
#pragma unroll
                    for (int n = 0; n < 2; ++n)
#pragma unroll
                        for (int j = 0; j < 4; ++j) o[n * 4 + j] = acc[ai][0][m][n][j] * fsigmoid(acc[ai][1][m][n][j]);
                    u32x4 w; w.x = cvt_pk_bf16(o[0], o[1]); w.y = cvt_pk_bf16(o[2], o[3]); w.z = cvt_pk_bf16(o[4], o[5]); w.w = cvt_pk_bf16(o[6], o[7]);
                    *(u32x4*)rowp = w; }
        } else {
            const int col = pn < 12 ? pn * BM : PJ_DQ + (pn - 16) * BM;
            const float sc = (pn < 2 || pn == 6 || pn == 7) ? C2_128 : ((pn == 16 || pn == 17) ? C2_64 : 1.0f);
            if (pn == 2 || pn == 3) {
                const int bb = u.pm >> 5, g32 = 8 * (u.pm & 31) + 2 * wr;
#pragma unroll
                for (int ai = 0; ai < 2; ++ai)
#pragma unroll
                    for (int m = 0; m < 4; ++m)
#pragma unroll
                        for (int bj = 0; bj < 2; ++bj) { const f32x4 v0 = acc[ai][bj][m][0], v1 = acc[ai][bj][m][1];
                            const int hh = (pn - 2) * 2 + bj;
                            bf16_t* dst = KF + ((((size_t)((bb * 4 + hh) * 256 + g32 + 4 * ai + (m >> 1)) * 8 + 2 * wc + (fq >> 1)) * 2 + (fq & 1)) * 32 + 16 * (m & 1) + fr) * 8;
                            u32x4 w; w.x = cvt_pk_bf16(v0[0], v0[1]); w.y = cvt_pk_bf16(v0[2], v0[3]); w.z = cvt_pk_bf16(v1[0], v1[1]); w.w = cvt_pk_bf16(v1[2], v1[3]);
                            *(u32x4*)dst = w; }
            } else if (pn == 4 || pn == 5) {
                const int bb = u.pm >> 5, g16 = 16 * (u.pm & 31) + 4 * wr;
#pragma unroll
                for (int ai = 0; ai < 2; ++ai)
#pragma unroll
                    for (int m = 0; m < 4; ++m)
#pragma unroll
                        for (int bj = 0; bj < 2; ++bj) { const int hh = (pn - 4) * 2 + bj;
                            bf16_t* dst = VF + ((((size_t)((bb * 4 + hh) * 512 + g16 + 8 * ai + m) * 4 + wc) * 2 + (fr >> 3)) * 32 + 8 * fq) * 8 + (fr & 7);
#pragma unroll
                            for (int n = 0; n < 2; ++n)
#pragma unroll
                                for (int j = 0; j < 4; ++j) { const float v = acc[ai][bj][m][n][j]; dst[(4 * n + j) * 8] = (bf16_t)(cvt_pk_bf16(v, v) & 0xffffu); } }
            } else {
            bf16_t* base = PJ + col + cw;
#pragma unroll
            for (int ai = 0; ai < 2; ++ai)
#pragma unroll
                for (int m = 0; m < 4; ++m) { bf16_t* rowp = base + (size_t)(row0 + ai * HALF + m * 16) * LDP;
#pragma unroll
                    for (int bj = 0; bj < 2; ++bj) { const f32x4 v0 = acc[ai][bj][m][0] * sc, v1 = acc[ai][bj][m][1] * sc;
                        u32x4 w; w.x = cvt_pk_bf16(v0[0], v0[1]); w.y = cvt_pk_bf16(v0[2], v0[3]); w.z = cvt_pk_bf16(v1[0], v1[1]); w.w = cvt_pk_bf16(v1[2], v1[3]);
                        *(u32x4*)(rowp + bj * HALF) = w; } }
            }
            if (pn == 8 || pn == 9) {
#pragma unroll
                for (int bj = 0; bj < 2; ++bj) { float mx = 0.f;
#pragma unroll
                    for (int ai = 0; ai < 2; ++ai)
#pragma unroll
                        for (int m = 0; m < 4; ++m) { const f32x4 a0 = acc[ai][bj][m][0], a1 = acc[ai][bj][m][1];
                            float q = (a0[0] * a0[0] + a0[1] * a0[1]) + (a0[2] * a0[2] + a0[3] * a0[3]) + (a1[0] * a1[0] + a1[1] * a1[1]) + (a1[2] * a1[2] + a1[3] * a1[3]);
                            q += shx<16>(q); q += shx<32>(q); mx = fmaxf(mx, q); }
                    mx = fmaxf(mx, shx<1>(mx)); mx = fmaxf(mx, shx<2>(mx)); mx = fmaxf(mx, shx<4>(mx)); mx = fmaxf(mx, shx<8>(mx));
                    if (fr == 0 && fq == 0) atomicMax(kn2 + ((u.pm >> 5) * 4 + (pn - 8) * 2 + bj) * 64, __float_as_uint(mx)); }
            }
            if (pn == 2 || pn == 3) {
                float* kp = kmean + (size_t)u.pm * 512 + (pn - 2) * BM + cw;
#pragma unroll
                for (int bj = 0; bj < 2; ++bj)
#pragma unroll
                    for (int n = 0; n < 2; ++n)
#pragma unroll
                        for (int j = 0; j < 4; ++j) { float s = 0.f;
#pragma unroll
                            for (int ai = 0; ai < 2; ++ai)
#pragma unroll
                                for (int m = 0; m < 4; ++m) s += acc[ai][bj][m][n][j];
                            s += shx<1>(s); s += shx<2>(s); s += shx<4>(s); s += shx<8>(s);
                            if (fr == 0) unsafeAtomicAdd(kp + bj * HALF + n * 4 + j, s); }
            }
        }
    }
};
struct EpiGate8 {
    static constexpr bool PERM = true, HOOK = false, AFTER_DRAIN = false, F8 = false, I8 = true;
    bf16_t* GT; const float* hr; const float* sg;
    __device__ __forceinline__ void operator()(const f32x4 (&acc)[2][2][4][2], const Unit& u, int wr, int wc, int fr, int fq) const {
        f32x4 cs[2][2];
#pragma unroll
        for (int bj = 0; bj < 2; ++bj)
#pragma unroll
            for (int n = 0; n < 2; ++n) cs[bj][n] = *(const f32x4*)(sg + u.pn * BM + bj * HALF + wc * 32 + 8 * fq + 4 * n) * (-LOG2E);
        float rs8[2][4];
#pragma unroll
        for (int ai = 0; ai < 2; ++ai)
#pragma unroll
            for (int m = 0; m < 4; ++m) rs8[ai][m] = hr[(size_t)u.pm * BM + ai * HALF + wr * 64 + m * 16 + fr];
        asm volatile("" ::: "memory");
        unsigned char* base = (unsigned char*)GT + ((size_t)u.pm * 32 + u.pn) * 65536 + (size_t)((unsigned)((wr * 4 + wc) * 64 + lane_id_fresh()) * 16u);
#pragma unroll
        for (int ai = 0; ai < 2; ++ai)
#pragma unroll
            for (int m = 0; m < 4; ++m) { u32x4 w; const float rs = rs8[ai][m];
#pragma unroll
                for (int bj = 0; bj < 2; ++bj) { const f32x4 v0 = acc[ai][bj][m][0], v1 = acc[ai][bj][m][1];
                    unsigned q[8];
#pragma unroll
                    for (int k = 0; k < 4; ++k) { const float a0 = v0[k], a1 = v1[k];
                        q[k] = (unsigned)fmaxf(__builtin_amdgcn_rcpf(1.0f + __builtin_amdgcn_exp2f((float)__float_as_int(a0) * (rs * cs[bj][0][k]))) * 255.0f + 0.5f, 1.0f);
                        q[4 + k] = (unsigned)fmaxf(__builtin_amdgcn_rcpf(1.0f + __builtin_amdgcn_exp2f((float)__float_as_int(a1) * (rs * cs[bj][1][k]))) * 255.0f + 0.5f, 1.0f); }
                    const unsigned lo = q[0] | (q[1] << 8) | (q[2] << 16) | (q[3] << 24), hi = q[4] | (q[5] << 8) | (q[6] << 16) | (q[7] << 24);
                    if (bj == 0) { w.x = lo; w.y = hi; } else { w.z = lo; w.w = hi; } }
                __builtin_nontemporal_store(w, (u32x4*)(base + (ai * 4 + m) * 8192)); }
    }
};
struct EpiMerge {
    static constexpr bool PERM = true, HOOK = true, AFTER_DRAIN = false, F8 = false;
    const unsigned char* GT; bf16_t* Y;
    __device__ __forceinline__ void mid(f32x4 (&acc)[2][2][4][2], const Unit& u, int z, int wr, int wc, int fr, int fq) const {
        const unsigned lin = (unsigned)opaque_v(((wr * 4 + wc) * 64 + fq * 16 + fr));
        const unsigned char* t0 = GT + ((size_t)u.pm * 32 + z * 8 + u.pn) * 65536;
#pragma unroll
        for (int ai = 0; ai < 2; ++ai) {
            u32x4 ga[4], gb[4];
#pragma unroll
            for (int m = 0; m < 4; ++m) { ga[m] = *(const u32x4*)(t0 + lin * 16u + (ai * 4 + m) * 8192); gb[m] = *(const u32x4*)(t0 + 8 * 65536 + lin * 16u + (ai * 4 + m) * 8192); }
            asm volatile("" ::: "memory");
#pragma unroll
            for (int m = 0; m < 4; ++m)
#pragma unroll
                for (int bj = 0; bj < 2; ++bj) { const u32x2 a = bj ? (u32x2){ga[m].z, ga[m].w} : (u32x2){ga[m].x, ga[m].y}, b = bj ? (u32x2){gb[m].z, gb[m].w} : (u32x2){gb[m].x, gb[m].y};
#pragma unroll
                    for (int k = 0; k < 4; ++k) { const float na = (float)((a.x >> (8 * k)) & 255u), nb = (float)((b.x >> (8 * k)) & 255u), nc = (float)((a.y >> (8 * k)) & 255u), nd = (float)((b.y >> (8 * k)) & 255u);
                        acc[ai][bj][m][0][k] *= na * __builtin_amdgcn_rcpf(nb); acc[ai][bj][m][1][k] *= nc * __builtin_amdgcn_rcpf(nd); } }
            asm volatile("" ::: "memory");
        }
    }
    __device__ __forceinline__ void operator()(const f32x4 (&acc)[2][2][4][2], const Unit& u, int wr, int wc, int fr, int fq) const {
        const int row0 = u.pm * BM + wr * 64 + fr, col0 = u.pn * BM + wc * 32 + 8 * fq;
        const unsigned lin = (unsigned)opaque_v(((wr * 4 + wc) * 64 + fq * 16 + fr));
        const unsigned char* t3 = GT + ((size_t)u.pm * 32 + 3 * 8 + u.pn) * 65536;
#pragma unroll
        for (int ai = 0; ai < 2; ++ai) {
            u32x4 gw[4];
#pragma unroll
            for (int m = 0; m < 4; ++m) gw[m] = *(const u32x4*)(t3 + lin * 16u + (ai * 4 + m) * 8192);
            asm volatile("" ::: "memory");
#pragma unroll
            for (int m = 0; m < 4; ++m)
#pragma unroll
                for (int bj = 0; bj < 2; ++bj) { const u32x2 g = bj ? (u32x2){gw[m].z, gw[m].w} : (u32x2){gw[m].x, gw[m].y};
                    const f32x4 v0 = acc[ai][bj][m][0] * (1.0f / 255.0f), v1 = acc[ai][bj][m][1] * (1.0f / 255.0f);
                    u32x4 w;
                    w.x = cvt_pk_bf16((float)(g.x & 255u) * v0[0], (float)((g.x >> 8) & 255u) * v0[1]);
                    w.y = cvt_pk_bf16((float)((g.x >> 16) & 255u) * v0[2], (float)(g.x >> 24) * v0[3]);
                    w.z = cvt_pk_bf16((float)(g.y & 255u) * v1[0], (float)((g.y >> 8) & 255u) * v1[1]);
                    w.w = cvt_pk_bf16((float)((g.y >> 16) & 255u) * v1[2], (float)(g.y >> 24) * v1[3]);
                    *(u32x4*)(Y + (size_t)(row0 + ai * HALF + m * 16) * DM + col0 + bj * HALF) = w; }
            asm volatile("" ::: "memory");
        }
    }
};

template <class D> struct SliceOrder {
    int slice, c;
    __device__ __forceinline__ bool next(int i, Unit& u) const { if (i > 0) return false; u.pm = slice * 32 + (c & 7) * 4 + ((c >> 3) & 3); u.pn = c >> 5; u.z = 0; return true; }
    __device__ __forceinline__ size_t a_off(const Unit& u) const { return (size_t)u.pm * (size_t)D::APANEL; }
    __device__ __forceinline__ size_t b_off(const Unit& u) const { return (size_t)u.pn * ((size_t)256 * D::LDB * 2); }
};
struct RowX {
    float* slots; gu32* cnt; gu32* tmo;
    static constexpr int XOFF = RING_BYTES + 4096;
    __device__ __forceinline__ void publish(const float (&part)[2][4], const Unit& u, int wr, int wc, int fr, int fq, LAS unsigned char* lds, int tid) const {
        LAS float* P = (LAS float*)(lds + XOFF);
#pragma unroll
        for (int ai = 0; ai < 2; ++ai)
#pragma unroll
            for (int m = 0; m < 4; ++m) { float v = part[ai][m]; v += shx<16>(v); v += shx<32>(v); if (fq == 0) P[(ai * HALF + wr * 64 + m * 16 + fr) * 4 + wc] = v; }
        asm volatile("s_waitcnt lgkmcnt(0)" ::: "memory"); __builtin_amdgcn_s_barrier(); asm volatile("" ::: "memory");
        if (tid < 256) { const float t = (P[tid * 4 + 0] + P[tid * 4 + 1]) + (P[tid * 4 + 2] + P[tid * 4 + 3]);
            __hip_atomic_store((unsigned*)slots + ((size_t)u.pm * 256 + tid) * 8 + u.pn, __float_as_uint(t), __ATOMIC_RELAXED, __HIP_MEMORY_SCOPE_AGENT); }
        asm volatile("s_waitcnt vmcnt(0)" ::: "memory"); __builtin_amdgcn_s_barrier(); asm volatile("" ::: "memory");
        if (tid == 0) __hip_atomic_fetch_add(cnt + 16 * u.pm, 1u, __ATOMIC_RELAXED, __HIP_MEMORY_SCOPE_AGENT);
    }
    __device__ __forceinline__ void collect(const Unit& u, LAS unsigned char* lds, int tid) const {
        LAS float* S = (LAS float*)(lds + XOFF + 4096);
        if (tid == 0) { unsigned sp = 0; while (__hip_atomic_load(cnt + 16 * u.pm, __ATOMIC_RELAXED, __HIP_MEMORY_SCOPE_AGENT) < 8u) { __builtin_amdgcn_s_sleep(1); if (++sp > (1u << 20)) { __hip_atomic_store(tmo, 1u, __ATOMIC_RELAXED, __HIP_MEMORY_SCOPE_AGENT); break; } }
            __builtin_amdgcn_fence(__ATOMIC_ACQUIRE, "agent"); asm volatile("s_waitcnt vmcnt(0)" ::: "memory"); }
        __builtin_amdgcn_s_barrier(); asm volatile("" ::: "memory");
        if (tid < 256) { const f32x4 a = *(const f32x4*)(slots + ((size_t)u.pm * 256 + tid) * 8), b = *(const f32x4*)(slots + ((size_t)u.pm * 256 + tid) * 8 + 4);
            const float t = ((a.x + a.y) + (a.z + a.w)) + ((b.x + b.y) + (b.z + b.w)); S[tid] = 1.0f / sqrtf(t * (1.0f / 2048.0f) + 1e-6f); }
        asm volatile("s_waitcnt vmcnt(0) lgkmcnt(0)" ::: "memory"); __builtin_amdgcn_s_barrier(); asm volatile("" ::: "memory");
    }
};
struct EpiResNorm {
    static constexpr bool PERM = true, HOOK = false, AFTER_DRAIN = true, F8 = false;
    const float* xf32; const bf16_t* xb; int xb_pitch, xb_off;
    bf16_t* xo; int xo_pitch, xo_off; float* outf;
    const float* res_gate; const float* res_gain;
    bf16_t* hout; const float* nx_gain; const float* nx_scale; const float* nx_shift; const float* hs;
    RowX ex1, ex2;
    __device__ __forceinline__ void stage_x(int ai, const Unit& u, int wid, int lane, LAS unsigned char* lds) const {
        const size_t grow0 = (size_t)u.pm * BM + ai * HALF;
        if (xf32) {
#pragma unroll
            for (int j = 0; j < 16; ++j) { const int r = j * 8 + wid; const int ch = lane ^ (r & 15);
                __builtin_amdgcn_global_load_lds((const unsigned*)(xf32 + (grow0 + r) * DM + u.pn * BM + ch * 4), (LAS unsigned*)(lds + r * 1024), 16, 0, 0); }
        } else {
#pragma unroll
            for (int j = 0; j < 8; ++j) { const int r = 2 * (j * 8 + wid) + (lane >> 5); const int ch = (lane & 31) ^ (r & 15);
                __builtin_amdgcn_global_load_lds((const unsigned*)(xb + (grow0 + r) * xb_pitch + xb_off + u.pn * BM + ch * 8), (LAS unsigned*)(lds + ai * 65536 + (j * 8 + wid) * 1024), 16, 0, 0); }
        }
    }
    __device__ __forceinline__ void residual_half(int ai, f32x4 (&acc)[2][2][4][2], float (&part)[2][4], const f32x4 (&g1)[2][2], const Unit& u, int wr, int wc, int fr, int fq, LAS unsigned char* lds) const {
        const LAS float* S = (const LAS float*)(lds + RowX::XOFF + 4096);
        const int col0 = u.pn * BM + wc * 32 + 8 * fq;
#pragma unroll
        for (int m = 0; m < 4; ++m) { const int rh = wr * 64 + m * 16 + fr, rl = ai * HALF + rh; const float r = S[rl]; const size_t grow = (size_t)u.pm * BM + rl; float q = 0.f;
#pragma unroll
            for (int bj = 0; bj < 2; ++bj) { const int c = col0 + bj * HALF;
                f32x4 x0, x1;
                if (xf32) { const int q0 = bj * 32 + wc * 8 + fq * 2; const LAS unsigned char* p = lds + rh * 1024; x0 = *(const LAS f32x4*)(p + ((q0 ^ fr) << 4)); x1 = *(const LAS f32x4*)(p + (((q0 + 1) ^ fr) << 4)); }
                else { const u32x4 w = *(const LAS u32x4*)(lds + ai * 65536 + rh * 512 + (((bj * 16 + wc * 4 + fq) ^ fr) << 4)); x0 = (f32x4){bf_lo(w.x), bf_hi(w.x), bf_lo(w.y), bf_hi(w.y)}; x1 = (f32x4){bf_lo(w.z), bf_hi(w.z), bf_lo(w.w), bf_hi(w.w)}; }
                f32x4 v0 = x0 + g1[bj][0] * (acc[ai][bj][m][0] * r), v1 = x1 + g1[bj][1] * (acc[ai][bj][m][1] * r);
                if (xo) { u32x4 w; w.x = cvt_pk_bf16(v0.x, v0.y); w.y = cvt_pk_bf16(v0.z, v0.w); w.z = cvt_pk_bf16(v1.x, v1.y); w.w = cvt_pk_bf16(v1.z, v1.w);
                    *(u32x4*)(xo + grow * xo_pitch + xo_off + c) = w;
                    v0 = (f32x4){bf_lo(w.x), bf_hi(w.x), bf_lo(w.y), bf_hi(w.y)}; v1 = (f32x4){bf_lo(w.z), bf_hi(w.z), bf_lo(w.w), bf_hi(w.w)}; }
                else { *(f32x4*)(outf + grow * DM + c) = v0; *(f32x4*)(outf + grow * DM + c + 4) = v1; }
                acc[ai][bj][m][0] = v0; acc[ai][bj][m][1] = v1;
                q += (v0.x * v0.x + v0.y * v0.y) + (v0.z * v0.z + v0.w * v0.w) + (v1.x * v1.x + v1.y * v1.y) + (v1.z * v1.z + v1.w * v1.w); }
            part[ai][m] = q;
            if (m & 1) asm volatile("" ::: "memory"); }
    }
    __device__ __forceinline__ void fused(f32x4 (&acc)[2][2][4][2], const Unit& u, int wr, int wc, int fr, int fq, LAS unsigned char* lds, int tid) const {
        const LAS float* S = (const LAS float*)(lds + RowX::XOFF + 4096);
        const int bt = u.pm >> 5, col0 = u.pn * BM + wc * 32 + 8 * fq, wid = wr * 4 + wc, lane = fq * 16 + fr;
        float part[2][4];
#pragma unroll
        for (int ai = 0; ai < 2; ++ai)
#pragma unroll
            for (int m = 0; m < 4; ++m) { float q = 0.f;
#pragma unroll
                for (int bj = 0; bj < 2; ++bj)
#pragma unroll
                    for (int n = 0; n < 2; ++n) { const f32x4 v = acc[ai][bj][m][n]; q += (v.x * v.x + v.y * v.y) + (v.z * v.z + v.w * v.w); }
                part[ai][m] = q; }
        ex1.publish(part, u, wr, wc, fr, fq, lds, tid);
        stage_x(0, u, wid, lane, lds); if (!xf32) stage_x(1, u, wid, lane, lds);
        f32x4 g1[2][2];
#pragma unroll
        for (int bj = 0; bj < 2; ++bj)
#pragma unroll
            for (int n = 0; n < 2; ++n) { const int c = col0 + bj * HALF + 4 * n; g1[bj][n] = *(const f32x4*)(res_gate + (size_t)bt * 12288 + c) * *(const f32x4*)(res_gain + c); }
        ex1.collect(u, lds, tid);
        residual_half(0, acc, part, g1, u, wr, wc, fr, fq, lds);
        if (xf32) { asm volatile("s_waitcnt lgkmcnt(0)" ::: "memory"); __builtin_amdgcn_s_barrier(); stage_x(1, u, wid, lane, lds); asm volatile("s_waitcnt vmcnt(0)" ::: "memory"); __builtin_amdgcn_s_barrier(); asm volatile("" ::: "memory"); }
        residual_half(1, acc, part, g1, u, wr, wc, fr, fq, lds);
        if (hout) {
            ex2.publish(part, u, wr, wc, fr, fq, lds, tid);
            f32x4 na[2][2], nb[2][2];
#pragma unroll
            for (int bj = 0; bj < 2; ++bj)
#pragma unroll
                for (int n = 0; n < 2; ++n) { const int c = col0 + bj * HALF + 4 * n; na[bj][n] = *(const f32x4*)(nx_gain + c) * (*(const f32x4*)(nx_scale + (size_t)bt * 12288 + c) + 1.0f); nb[bj][n] = *(const f32x4*)(nx_shift + (size_t)bt * 12288 + c); }
            ex2.collect(u, lds, tid);
            const float qinv = 1.0f / hs[bt];
#pragma unroll
            for (int ai = 0; ai < 2; ++ai)
#pragma unroll
                for (int m = 0; m < 4; ++m) { const int rl = ai * HALF + wr * 64 + m * 16 + fr; const float r = S[rl]; const size_t grow = (size_t)u.pm * BM + rl;
#pragma unroll
                    for (int bj = 0; bj < 2; ++bj) { const f32x4 h0 = ((acc[ai][bj][m][0] * r) * na[bj][0] + nb[bj][0]) * qinv, h1 = ((acc[ai][bj][m][1] * r) * na[bj][1] + nb[bj][1]) * qinv;
                        u32x2 w; w.x = pk4_i8(h0.x, h0.y, h0.z, h0.w); w.y = pk4_i8(h1.x, h1.y, h1.z, h1.w);
                        *(u32x2*)((unsigned char*)hout + grow * DM + col0 + bj * HALF) = w; } }
        }
    }
};
}

#define XB_TMO      128
#define XB_XCNT(j)  (256  + 64 * (j))
#define XB_XSUB(j)  (1280 + 64 * (j))
#define XB_XGEN(j)  (2304 + 64 * (j))
#define XB_TOP      3328
#define XB_TOPGEN   3392
#define XCD_BAR_WORDS 3456
#define XB_SPIN_CAP (1u << 18)
__device__ __forceinline__ unsigned xb_ld(unsigned* p)              { return __hip_atomic_load(p, __ATOMIC_RELAXED, __HIP_MEMORY_SCOPE_AGENT); }
__device__ __forceinline__ unsigned xb_add(unsigned* p, unsigned v) { return __hip_atomic_fetch_add(p, v, __ATOMIC_RELAXED, __HIP_MEMORY_SCOPE_AGENT); }
__device__ __forceinline__ unsigned xb_xcc_id() { return (unsigned)__builtin_amdgcn_s_getreg((3 << 11) | 20) & 0xFu; }
#define XB_SPIN(cond, bar) do { unsigned _sp = 0; while (cond) { __builtin_amdgcn_s_sleep(1); \
    if ((++_sp & 255u) == 0u) { if (xb_ld(&(bar)[XB_TMO])) break; if (_sp > XB_SPIN_CAP) { atomicAdd(&(bar)[XB_TMO], 1u); break; } } } } while (0)
struct XcdBarrier { unsigned* bar; unsigned x; volatile LAS unsigned* st; int wave; };
__device__ __forceinline__ XcdBarrier xcd_barrier_post(unsigned* bar, volatile LAS unsigned* st, int wave) {
    XcdBarrier b; b.bar = bar; b.x = xb_xcc_id(); b.st = st; b.wave = wave;
    if (wave == 0 && lane_id_fresh() == 0) (void)xb_add(&bar[XB_XCNT(b.x)], 1u);
    return b;
}
__device__ __forceinline__ void xcd_barrier_complete(unsigned* bar, unsigned x, unsigned& nloc, unsigned& nx) {
    const unsigned G = gridDim.x * gridDim.y * gridDim.z;
    unsigned sum, cnt, mine, sp = 0u;
    for (;;) {
        sum = 0u; cnt = 0u; mine = 0u;
#pragma unroll
        for (unsigned j = 0; j < 16; ++j) { const unsigned c = xb_ld(&bar[XB_XCNT(j)]); sum += c; cnt += (c > 0u) ? 1u : 0u; mine = (j == x) ? c : mine; }
        if (sum == G) break;
        __builtin_amdgcn_s_sleep(1);
        if ((++sp & 255u) == 0u) { if (xb_ld(&bar[XB_TMO])) break; if (sp > XB_SPIN_CAP) { atomicAdd(&bar[XB_TMO], 1u); break; } }
    }
    nloc = mine > 0u ? mine : 1u; nx = cnt > 0u ? cnt : 1u;
}
__device__ __forceinline__ void xcd_barrier(const XcdBarrier& b) {
    asm volatile("s_waitcnt vmcnt(0)" ::: "memory");
    __syncthreads();
    if (b.wave == 0 && lane_id_fresh() == 0) {
        unsigned* bar = b.bar; asm volatile("" : "+s"(bar));
        __builtin_amdgcn_s_waitcnt(0);
        unsigned nloc = b.st[0], nx = b.st[1];
        if (nloc == 0u) { xcd_barrier_complete(bar, b.x, nloc, nx); b.st[0] = nloc; b.st[1] = nx; }
        const unsigned old = xb_add(&bar[XB_XSUB(b.x)], 1u);
        const unsigned gen = old / nloc;
        if (old + 1u == (gen + 1u) * nloc) {
            __builtin_amdgcn_fence(__ATOMIC_RELEASE, "agent");
            asm volatile("s_waitcnt vmcnt(0)" ::: "memory");
            const unsigned og = xb_add(&bar[XB_TOP], 1u);
            const unsigned tg = og / nx;
            if (og + 1u == (tg + 1u) * nx) xb_add(&bar[XB_TOPGEN], 1u);
            else XB_SPIN(xb_ld(&bar[XB_TOPGEN]) == tg, bar);
            __builtin_amdgcn_fence(__ATOMIC_ACQUIRE, "agent");
            xb_add(&bar[XB_XGEN(b.x)], 1u);
            asm volatile("s_waitcnt vmcnt(0)" ::: "memory");
        } else {
            XB_SPIN(xb_ld(&bar[XB_XGEN(b.x)]) == gen, bar);
            __builtin_amdgcn_fence(__ATOMIC_ACQUIRE, "agent");
            asm volatile("s_waitcnt vmcnt(0)" ::: "memory");
        }
    }
    __syncthreads();
}

struct Args {
    const float *x, *c, *rel_bias, *w_mod, *b_mod, *mix_pre, *mix_post, *w_in, *fox_bias, *conv_w, *conv_b, *conv_g, *conv_beta, *sinks,
                *w_br_a, *w_br_b, *w_br_c, *w_br_d, *w_out, *ffn_pre, *ffn_post, *w_gate, *w_up, *w_down;
    float* out; unsigned char* ws; int ph_lo, ph_hi;
};
struct Frame {
    LAS unsigned char* lds; volatile LAS unsigned* MISC; gu32* ctl;
    int wave, G;
    __device__ __forceinline__ int lane_() const { return lane_id_fresh(); }
    __device__ __forceinline__ int tid_() const { return wave * 64 + lane_id_fresh(); }
    unsigned char* ws;
};

__device__ __forceinline__ int t5_bucket(int d) {
    if (d < 16) return d;
    int b = 15;
    b += (d >= 16); b += (d >= 21); b += (d >= 27); b += (d >= 35); b += (d >= 46); b += (d >= 59); b += (d >= 77); b += (d >= 99);
    b += (d >= 128); b += (d >= 166); b += (d >= 216); b += (d >= 280); b += (d >= 363); b += (d >= 470); b += (d >= 609); b += (d >= 790);
    return b;
}

__device__ __forceinline__ void transpose_item(const float* W, int ldw, int n0s, bf16* WT, int K, int drow0, int k0, LAS float* scr, int lane) {
#pragma unroll 8
    for (int i = 0; i < 32; ++i) { const int kk = 2 * i + (lane >> 5); scr[kk * 33 + (lane & 31)] = W[(size_t)(k0 + kk) * ldw + n0s + (lane & 31)]; }
    LDS_WAIT(); asm volatile("" ::: "memory");
    const int c = lane & 7;
#pragma unroll
    for (int j = 0; j < 4; ++j) { const int n = (lane >> 3) + 8 * j; const LAS float* s = scr + (8 * c) * 33 + n;
        u32x4 o; o.x = pk2(s[0 * 33], s[1 * 33]); o.y = pk2(s[2 * 33], s[3 * 33]); o.z = pk2(s[4 * 33], s[5 * 33]); o.w = pk2(s[6 * 33], s[7 * 33]);
        *(GAS u32x4*)(WT + (size_t)(drow0 + n) * K + k0 + 8 * c) = o; }
    LDS_WAIT(); asm volatile("" ::: "memory");
}
__device__ __forceinline__ void transpose_item8(const float* W, int ldw, int n0s, unsigned char* W8, int K, int drow0, int k0, LAS float* scr, int lane) {
#pragma unroll 8
    for (int i = 0; i < 32; ++i) { const int kk = 2 * i + (lane >> 5); scr[kk * 33 + (lane & 31)] = W[(size_t)(k0 + kk) * ldw + n0s + (lane & 31)] * 64.0f; }
    LDS_WAIT(); asm volatile("" ::: "memory");
    const int c = lane & 3;
#pragma unroll
    for (int j = 0; j < 2; ++j) { const int n = (lane >> 2) + 16 * j; const LAS float* s = scr + (16 * c) * 33 + n;
        u32x4 o; o.x = pk4_fp8(s[0 * 33], s[1 * 33], s[2 * 33], s[3 * 33]); o.y = pk4_fp8(s[4 * 33], s[5 * 33], s[6 * 33], s[7 * 33]);
        o.z = pk4_fp8(s[8 * 33], s[9 * 33], s[10 * 33], s[11 * 33]); o.w = pk4_fp8(s[12 * 33], s[13 * 33], s[14 * 33], s[15 * 33]);
        *(GAS u32x4*)(W8 + (size_t)(drow0 + n) * K + k0 + 16 * c) = o; }
    LDS_WAIT(); asm volatile("" ::: "memory");
}
__device__ __forceinline__ void transpose_item_i8(const float* W, int ldw, int n0s, unsigned char* W8, int K, int drow0, int k0, LAS float* scr, int lane, const LAS float* inv) {
#pragma unroll
    for (int i = 0; i < 8; ++i) { const int kk = 8 * i + (lane >> 3); const f32x4 v = *(const f32x4*)(W + (size_t)(k0 + kk) * ldw + n0s + 4 * (lane & 7));
        LAS float* d = scr + kk * 33 + 4 * (lane & 7); d[0] = v.x; d[1] = v.y; d[2] = v.z; d[3] = v.w; }
    LDS_WAIT(); asm volatile("" ::: "memory");
    const int c = lane & 3;
#pragma unroll
    for (int j = 0; j < 2; ++j) { const int n = (lane >> 2) + 16 * j; const LAS float* s = scr + (16 * c) * 33 + n; const float f = inv[n];
        u32x4 o; o.x = pk4_i8(s[0 * 33] * f, s[1 * 33] * f, s[2 * 33] * f, s[3 * 33] * f); o.y = pk4_i8(s[4 * 33] * f, s[5 * 33] * f, s[6 * 33] * f, s[7 * 33] * f);
        o.z = pk4_i8(s[8 * 33] * f, s[9 * 33] * f, s[10 * 33] * f, s[11 * 33] * f); o.w = pk4_i8(s[12 * 33] * f, s[13 * 33] * f, s[14 * 33] * f, s[15 * 33] * f);
        *(GAS u32x4*)(W8 + (size_t)(drow0 + n) * K + k0 + 16 * c) = o; }
    LDS_WAIT(); asm volatile("" ::: "memory");
}
__device__ __forceinline__ int map_in_row(int c) {
    if (c >= 3072 && c < 4096) { const int u = c - 3072; return u < 512 ? 3072 + 256 * (u >> 7) + (u & 127) : 3072 + 256 * ((u - 512) >> 7) + 128 + (u & 127); }
    return c;
}
__device__ __forceinline__ void p0_prologue(Frame& F, const Args& a) {
    {
        LAS float* ca = (LAS float*)F.lds;
        LAS float* red = (LAS float*)(F.lds + 16384);
        for (int i = F.tid_(); i < 2 * DM; i += 512) { const float v = a.c[i]; ca[i] = v * fsigmoid(v); }
        __syncthreads();
        float* MOD = (float*)(F.ws + WS_MOD);
        for (int it = bid_fresh(); it < 2 * 192; it += F.G) {
            const int l = it / 192, n = (it % 192) * 64 + F.lane_();
            const float* w = a.w_mod + (size_t)l * DM * 12288 + n;
            float a0 = 0.f, a1 = 0.f; const int kb = F.wave * 256;
#pragma unroll 8
            for (int k = 0; k < 256; ++k) { const float wv = w[(size_t)(kb + k) * 12288]; a0 += ca[kb + k] * wv; a1 += ca[DM + kb + k] * wv; }
            red[(F.wave * 2 + 0) * 64 + F.lane_()] = a0; red[(F.wave * 2 + 1) * 64 + F.lane_()] = a1;
            __syncthreads();
            if (F.tid_() < 128) { const int b = F.tid_() >> 6; float s = a.b_mod[l * 12288 + n];
#pragma unroll
                for (int w8 = 0; w8 < 8; ++w8) s += red[(w8 * 2 + b) * 64 + F.lane_()];
                MOD[(size_t)(l * 2 + b) * 12288 + n] = s; }
            __syncthreads();
        }
    }
    LAS float* scr = (LAS float*)(F.lds + F.wave * 16384);
    const int gw = bid_fresh() * 8 + F.wave, NGW = F.G * 8;
    constexpr int I_IN = 0, I_BR = 8 * 64, I_OUT = 32 * 64, I_G = 32 * 176, I_D = 88 * 64;
    constexpr int I_LAYER = I_IN + 4 * I_BR + I_OUT + I_D;
    for (int it = gw; it < DEPTH * I_LAYER; it += NGW) {
        const int l = it / I_LAYER; int r = it - l * I_LAYER;
        unsigned char* wl = F.ws + WS_W + (size_t)l * W_LAYER;
        if (r < I_IN) { const int kb = r / 152, nb = r % 152, c = nb * 32;
            transpose_item(a.w_in + (size_t)l * DM * INW, INW, c < 3072 ? c : c + 4, (bf16*)(wl + W_IN), DM, map_in_row(c), kb * 64, scr, F.lane_()); continue; }
        r -= I_IN;
        if (r < 4 * I_BR) { const int z = r / I_BR, q = r % I_BR, kb = q / 64, nb = q % 64;
            const float* src = (z == 0 ? a.w_br_a : z == 1 ? a.w_br_b : z == 2 ? a.w_br_c : a.w_br_d) + (size_t)l * 512 * DM;
            transpose_item(src, DM, nb * 32, (bf16*)(wl + W_BR) + z * 512, DM, nb * 32, kb * 64, scr, F.lane_()); continue; }
        r -= 4 * I_BR;
        if (r < I_OUT) { const int kb = r / 64, nb = r % 64;
            transpose_item(a.w_out + (size_t)l * DM * DM, DM, nb * 32, (bf16*)(wl + W_OUT), DM, nb * 32, kb * 64, scr, F.lane_()); continue; }
        r -= I_OUT;
        { const int kb = r / 64, nb = r % 64;
            transpose_item(a.w_down + (size_t)l * DFF * DM, DM, nb * 32, (bf16*)(wl + W_DN), DFF, nb * 32, kb * 64, scr, F.lane_()); }
    }
    {
        LAS float* cm = (LAS float*)(F.lds + RING_BYTES + 4096);
        LAS float* inv = cm + 256;
        const int lane = F.lane_();
        __syncthreads();
        for (int it = bid_fresh(); it < DEPTH * (2 * 176 + 408); it += F.G) {
            const int l = it / 760, q = it % 760;
            unsigned char* wl = F.ws + WS_W + (size_t)l * W_LAYER;
            const float* src; int ldw; unsigned char* dst; float* sc;
            if (q < 352) { const int up = q / 176, c0 = (q % 176) * 32, drow0 = 256 * (c0 >> 7) + (c0 & 127) + up * 128;
                src = (up ? a.w_up : a.w_gate) + (size_t)l * DM * DFF + c0; ldw = DFF; dst = wl + W_GU + (size_t)drow0 * DM; sc = (float*)(F.ws + WS_SW) + (size_t)l * 2 * DFF + drow0; }
            else { const int c = (q - 352) * 32, drow0 = c < 19 * 256 ? map_in_row(c) : c;
                src = a.w_in + (size_t)l * DM * INW + (c < 3072 ? c : c + 4); ldw = INW; dst = wl + W_IN + (size_t)drow0 * DM; sc = (float*)(F.ws + WS_SG) + (size_t)l * 13056 + drow0; }
            LAS unsigned char* s16 = (LAS unsigned char*)scr;
            f32x4 mx = {0.f, 0.f, 0.f, 0.f};
#pragma unroll 1
            for (int ch = 0; ch < 4; ++ch) { const int k0 = (F.wave * 4 + ch) * 64;
#pragma unroll
                for (int i = 0; i < 8; ++i) { const int kk = 8 * i + (lane >> 3); const f32x4 v = *(const f32x4*)(src + (size_t)(k0 + kk) * ldw + 4 * (lane & 7));
                    mx.x = fmaxf(mx.x, fabsf(v.x)); mx.y = fmaxf(mx.y, fabsf(v.y)); mx.z = fmaxf(mx.z, fabsf(v.z)); mx.w = fmaxf(mx.w, fabsf(v.w));
                    *(LAS u32x2*)(s16 + ch * 4096 + kk * 64 + 8 * (lane & 7)) = (u32x2){cvt_pk_bf16(v.x, v.y), cvt_pk_bf16(v.z, v.w)}; } }
#pragma unroll
            for (int e = 0; e < 4; ++e) { float t = mx[e]; t = fmaxf(t, shx<8>(t)); t = fmaxf(t, shx<16>(t)); t = fmaxf(t, shx<32>(t)); mx[e] = t; }
            if (lane < 8) *(LAS f32x4*)(cm + F.wave * 32 + 4 * lane) = mx;
            __syncthreads();
            { const int t = F.tid_(); if (t < 32) { float m8 = 1e-30f;
#pragma unroll
                for (int w = 0; w < 8; ++w) m8 = fmaxf(m8, cm[w * 32 + t]);
                inv[t] = 127.0f / m8; sc[t] = m8 * (1.0f / 127.0f); } }
            __syncthreads();
            { const int c = lane & 3;
#pragma unroll 1
                for (int ch = 0; ch < 4; ++ch) { const int k0 = (F.wave * 4 + ch) * 64;
#pragma unroll
                    for (int jj = 0; jj < 2; ++jj) { const int n = (lane >> 2) + 16 * jj; const LAS unsigned short* sp = (const LAS unsigned short*)(s16 + ch * 4096 + (16 * c) * 64 + n * 2); const float f = inv[n];
                        float e[16];
#pragma unroll
                        for (int i2 = 0; i2 < 16; ++i2) e[i2] = __builtin_bit_cast(float, (unsigned)sp[i2 * 32] << 16) * f;
                        u32x4 o; o.x = pk4_i8(e[0], e[1], e[2], e[3]); o.y = pk4_i8(e[4], e[5], e[6], e[7]); o.z = pk4_i8(e[8], e[9], e[10], e[11]); o.w = pk4_i8(e[12], e[13], e[14], e[15]);
                        *(GAS u32x4*)(dst + (size_t)n * DM + k0 + 16 * c) = o; } } }
            __syncthreads();
        }
    }
}

__device__ __forceinline__ void h2_scales(Frame& F, const Args& a) {
    LAS float* red = (LAS float*)(F.lds + RING_BYTES + 4096);
    const float* MOD = (const float*)(F.ws + WS_MOD);
    const int t = F.tid_(), lane = t & 63, c = 4 * t;
#pragma unroll
    for (int q = 0; q < 4; ++q) { const int l = q >> 1; const float* modq = MOD + (size_t)q * 12288;
        const f32x4 g = *(const f32x4*)(a.ffn_pre + l * DM + c), sc = *(const f32x4*)(modq + 8192 + c), sf = *(const f32x4*)(modq + 6144 + c);
        const f32x4 na = g * (sc + 1.0f);
        float sm = (na.x * na.x + na.y * na.y) + (na.z * na.z + na.w * na.w), mx = fmaxf(fmaxf(fabsf(sf.x), fabsf(sf.y)), fmaxf(fabsf(sf.z), fabsf(sf.w)));
        sm += shx<1>(sm); sm += shx<2>(sm); sm += shx<4>(sm); sm += shx<8>(sm); sm += shx<16>(sm); sm += shx<32>(sm);
        mx = fmaxf(mx, shx<1>(mx)); mx = fmaxf(mx, shx<2>(mx)); mx = fmaxf(mx, shx<4>(mx)); mx = fmaxf(mx, shx<8>(mx)); mx = fmaxf(mx, shx<16>(mx)); mx = fmaxf(mx, shx<32>(mx));
        if (lane == 0) { red[(q * 8 + F.wave) * 2] = sm; red[(q * 8 + F.wave) * 2 + 1] = mx; } }
    __syncthreads();
    if (t < 4) { float sm = 0.f, mx = 0.f;
#pragma unroll
        for (int w = 0; w < 8; ++w) { sm += red[(t * 8 + w) * 2]; mx = fmaxf(mx, red[(t * 8 + w) * 2 + 1]); }
        ((float*)(F.ws + WS_HS))[t] = (4.75f * sqrtf(sm * (1.0f / DM)) + mx) * (1.0f / 127.0f); }
    __syncthreads();
}

struct NormArgs {
    const float* xin; float* xout; const bf16* yo; bf16* hout; float* lf; unsigned char* h8; float* hr;
    const float* res_gate; const float* res_gain;
    const float* nx_gain; const float* nx_scale; const float* nx_shift;
    const float* wf; const float* fox_b;
    int flags;
};
__device__ __forceinline__ void norm_phase(Frame& F, const NormArgs& n) {
    const bool RES = n.flags & 1, NEXT = n.flags & 2, FG = n.flags & 4;
    const int tid = opaque_v(F.tid_()), lane = tid & 63, wave = __builtin_amdgcn_readfirstlane(tid >> 6);
    LAS f32x4* wfl = (LAS f32x4*)F.lds;
    LAS f32x4* pG1 = (LAS f32x4*)(F.lds + 32768);
    LAS f32x4* pNA = (LAS f32x4*)(F.lds + 40960);
    LAS f32x4* pNB = (LAS f32x4*)(F.lds + 49152);
    const int rows_per = M / (F.G * 8);
    const int b = (bid_fresh() * 8 * rows_per) / SEQ;
    if (FG) {
        for (int s = tid; s < DM; s += 512) { const int l = s & 63, ji = s >> 6, j = ji >> 2, i = ji & 3, c = 256 * j + 4 * l + i;
            wfl[s] = *(const f32x4*)(n.wf + (size_t)c * INW + 3072); }
    }
    { const int s = tid, c = 4 * s;
        if (RES) { const f32x4 g = *(const f32x4*)(n.res_gate + (size_t)b * 12288 + c), w = *(const f32x4*)(n.res_gain + c); pG1[s] = g * w; }
        if (NEXT) { const f32x4 g = *(const f32x4*)(n.nx_gain + c), sc = *(const f32x4*)(n.nx_scale + (size_t)b * 12288 + c); pNA[s] = g * (sc + 1.0f); pNB[s] = *(const f32x4*)(n.nx_shift + (size_t)b * 12288 + c); } }
    __syncthreads();
    const int gw = bid_fresh() * 8 + wave;
    const int row_lo = gw * rows_per;
    float fb[4] = {0.f, 0.f, 0.f, 0.f};
    if (FG) { fb[0] = n.fox_b[0]; fb[1] = n.fox_b[1]; fb[2] = n.fox_b[2]; fb[3] = n.fox_b[3]; }
    const bool XB = n.flags & 8;
    f32x4 nx[8]; u32x2 nxb[8], ny[8];
#define NORM_LOAD(row_) do { const size_t r_ = (size_t)(row_); \
        if (XB) { _Pragma("unroll") for (int j = 0; j < 8; ++j) nxb[j] = *(const u32x2*)((const bf16*)n.xin + r_ * (2 * DM) + DM + 256 * j + 4 * lane); } \
        else { _Pragma("unroll") for (int j = 0; j < 8; ++j) nx[j] = *(const f32x4*)(n.xin + r_ * DM + 256 * j + 4 * lane); } \
        if (RES) { _Pragma("unroll") for (int j = 0; j < 8; ++j) ny[j] = *(const u32x2*)(n.yo + r_ * DM + 256 * j + 4 * lane); } } while (0)
#pragma unroll
    for (int j = 0; j < 8; ++j) { nx[j] = (f32x4){0.f, 0.f, 0.f, 0.f}; nxb[j] = (u32x2){0u, 0u}; ny[j] = (u32x2){0u, 0u}; }
    NORM_LOAD(row_lo);
#pragma unroll 1
    for (int rr = 0; rr < rows_per; ++rr) {
        const size_t row = (size_t)(row_lo + rr);
        f32x4 v[8]; u32x2 y[8];
#pragma unroll
        for (int j = 0; j < 8; ++j) { v[j] = XB ? (f32x4){bf_lo(nxb[j].x), bf_hi(nxb[j].x), bf_lo(nxb[j].y), bf_hi(nxb[j].y)} : nx[j]; y[j] = ny[j]; }
        if (rr + 1 < rows_per) NORM_LOAD(row + 1);
        if (RES) {
            float ss = 0.f;
#pragma unroll
            for (int j = 0; j < 8; ++j) {
                const float y0 = bf_lo(y[j].x), y1 = bf_hi(y[j].x), y2 = bf_lo(y[j].y), y3 = bf_hi(y[j].y); ss += (y0 * y0 + y1 * y1) + (y2 * y2 + y3 * y3); }
            const float r = 1.0f / sqrtf(wave_sum(ss) * (1.0f / DM) + RMS_EPS);
#pragma unroll
            for (int j = 0; j < 8; ++j) { const f32x4 yy = (f32x4){bf_lo(y[j].x), bf_hi(y[j].x), bf_lo(y[j].y), bf_hi(y[j].y)};
                v[j] = v[j] + pG1[64 * j + lane] * (yy * r);
                if (n.flags & 16) { u32x2 w; w.x = cvt_pk_bf16(v[j].x, v[j].y); w.y = cvt_pk_bf16(v[j].z, v[j].w); *(u32x2*)((bf16*)n.xout + row * (2 * DM) + DM + 256 * j + 4 * lane) = w;
                    v[j] = (f32x4){bf_lo(w.x), bf_hi(w.x), bf_lo(w.y), bf_hi(w.y)}; }
                else *(f32x4*)(n.xout + row * DM + 256 * j + 4 * lane) = v[j]; }
        }
        if (NEXT) {
            float ss = 0.f;
#pragma unroll
            for (int j = 0; j < 8; ++j) ss += (v[j].x * v[j].x + v[j].y * v[j].y) + (v[j].z * v[j].z + v[j].w * v[j].w);
            const float r = 1.0f / sqrtf(wave_sum(ss) * (1.0f / DM) + RMS_EPS);
            float f0 = 0.f, f1 = 0.f, f2 = 0.f, f3 = 0.f, hmx = 1e-30f;
#pragma unroll
            for (int j = 0; j < 8; ++j) { const f32x4 h = (v[j] * r) * pNA[64 * j + lane] + pNB[64 * j + lane];
                if (n.hout) { u32x2 w; w.x = pk2(h.x, h.y); w.y = pk2(h.z, h.w); *(u32x2*)(n.hout + row * DM + 256 * j + 4 * lane) = w; }
                if (n.h8) { v[j] = h; hmx = fmaxf(hmx, fmaxf(fmaxf(fabsf(h.x), fabsf(h.y)), fmaxf(fabsf(h.z), fabsf(h.w)))); }
                if (FG) { const f32x4 w0 = wfl[(j * 4 + 0) * 64 + lane], w1 = wfl[(j * 4 + 1) * 64 + lane], w2 = wfl[(j * 4 + 2) * 64 + lane], w3 = wfl[(j * 4 + 3) * 64 + lane];
                    f0 += h.x * w0.x + h.y * w1.x + h.z * w2.x + h.w * w3.x; f1 += h.x * w0.y + h.y * w1.y + h.z * w2.y + h.w * w3.y;
                    f2 += h.x * w0.z + h.y * w1.z + h.z * w2.z + h.w * w3.z; f3 += h.x * w0.w + h.y * w1.w + h.z * w2.w + h.w * w3.w; }
                asm volatile("" ::: "memory"); }
            if (n.h8) {
                hmx = fmaxf(hmx, shx<1>(hmx)); hmx = fmaxf(hmx, shx<2>(hmx)); hmx = fmaxf(hmx, shx<4>(hmx)); hmx = fmaxf(hmx, shx<8>(hmx)); hmx = fmaxf(hmx, shx<16>(hmx)); hmx = fmaxf(hmx, shx<32>(hmx));
                const float qi = 127.0f / hmx;
                if (lane == 0) n.hr[row] = hmx * (1.0f / 127.0f);
#pragma unroll
                for (int j = 0; j < 8; ++j) *(unsigned*)(n.h8 + row * (2 * DM) + 256 * j + 4 * lane) = pk4_i8(v[j].x * qi, v[j].y * qi, v[j].z * qi, v[j].w * qi); }
            if (FG) { f0 = wave_sum(f0); f1 = wave_sum(f1); f2 = wave_sum(f2); f3 = wave_sum(f3);
                if (lane == 0) { float z[4] = {f0 + fb[0], f1 + fb[1], f2 + fb[2], f3 + fb[3]}; f32x4 o;
#pragma unroll
                    for (int k = 0; k < 4; ++k) { const float t = z[k]; o[k] = fminf(t, 0.f) - log1pf(expf(-fabsf(t))); }
                    *(f32x4*)(n.lf + row * 4) = o; } }
        }
    }
#undef NORM_LOAD
    __syncthreads();
}
__device__ __forceinline__ void fox_scan(Frame& F, int bh) {
    const int tid = opaque_v(F.tid_()), lane = tid & 63, wave = __builtin_amdgcn_readfirstlane(tid >> 6);
    const int b = bh >> 2, hd = bh & 3; const float* lf = (const float*)(F.ws + WS_LF); float* kb = (float*)(F.ws + WS_KB) + (size_t)bh * SEQ;
    LAS float* wtot = (LAS float*)(F.lds + RING_BYTES + 64);
    float v[16]; float run = 0.f;
#pragma unroll
    for (int k = 0; k < 16; ++k) { run += lf[((size_t)b * SEQ + tid * 16 + k) * 4 + hd]; v[k] = run; }
    float inc = run;

    { float t; t = shup<1>(inc, lane); if (lane >= 1) inc += t; t = shup<2>(inc, lane); if (lane >= 2) inc += t; t = shup<4>(inc, lane); if (lane >= 4) inc += t; t = shup<8>(inc, lane); if (lane >= 8) inc += t; t = shup<16>(inc, lane); if (lane >= 16) inc += t; t = shup<32>(inc, lane); if (lane >= 32) inc += t; }
    if (lane == 63) wtot[wave] = inc;
    __syncthreads();
    float off = inc - run;
    for (int w = 0; w < wave; ++w) off += wtot[w];
#pragma unroll
    for (int k = 0; k < 16; ++k) kb[tid * 16 + k] = -(v[k] + off) * LOG2E;
    __syncthreads();
}

namespace att {
#define KSWZ(row, colB) ((row) * 256 + ((colB) ^ (((row) & 7) << 4)))
#define KSWZ64(row, colB) ((row) * 128 + ((colB) ^ (((row) & 7) << 4)))
#define SBAR() __builtin_amdgcn_sched_barrier(0)
__device__ __forceinline__ int crow(int r, int hi) { return (r & 3) + 8 * (r >> 2) + 4 * hi; }
template <int NC> __device__ __forceinline__ int v_st(int k, int c) { const int kk = (k & ~0xC) | ((k & 4) << 1) | ((k & 8) >> 1); return ((kk >> 3) * NC + (c >> 5)) * 512 + ((kk & 7) * 32 + (c & 31)) * 2; }
__device__ __forceinline__ int v_rd_base(int lane) { return ((lane & 3) << 3) | (((lane >> 2) & 3) << 6) | (((lane >> 4) & 1) << 5) | (((lane >> 5) & 1) << 8); }

__device__ __forceinline__ void softmax_tile(f32x16& p0, f32x16& p1, float& m_reg, float& l_reg, float& alpha, bf16x8& pa0, bf16x8& pa1, bf16x8& pa2, bf16x8& pa3) {
    float pmax = p0[0];
#pragma unroll
    for (int r = 1; r < 16; ++r) pmax = fmaxf(pmax, p0[r]);
#pragma unroll
    for (int r = 0; r < 16; ++r) pmax = fmaxf(pmax, p1[r]);
    { auto rr = __builtin_amdgcn_permlane32_swap(__float_as_uint(pmax), __float_as_uint(pmax), false, false);
      pmax = fmaxf(__uint_as_float(rr[0]), __uint_as_float(rr[1])); }
    const float mn = fmaxf(m_reg, pmax);
    alpha = __builtin_amdgcn_exp2f(m_reg - mn); m_reg = mn;
    float ps = 0.f;
#pragma unroll
    for (int r = 0; r < 16; ++r) { p0[r] = __builtin_amdgcn_exp2f(p0[r] - mn); ps += p0[r]; }
#pragma unroll
    for (int r = 0; r < 16; ++r) { p1[r] = __builtin_amdgcn_exp2f(p1[r] - mn); ps += p1[r]; }
    { auto rr = __builtin_amdgcn_permlane32_swap(__float_as_uint(ps), __float_as_uint(ps), false, false);
      ps = __uint_as_float(rr[0]) + __uint_as_float(rr[1]); }
    l_reg = l_reg * alpha + ps;
#define PK4(P, B_, OUT) do { unsigned a0 = cvt_pk_bf16(P[B_+0], P[B_+1]), a1 = cvt_pk_bf16(P[B_+2], P[B_+3]);                          \
        unsigned b0 = cvt_pk_bf16(P[B_+4], P[B_+5]), b1 = cvt_pk_bf16(P[B_+6], P[B_+7]);                                             \
        auto r0 = __builtin_amdgcn_permlane32_swap(a0, b0, false, false); auto r1 = __builtin_amdgcn_permlane32_swap(a1, b1, false, false); \
        u32x4 w = {r0[0], r1[0], r0[1], r1[1]}; OUT = __builtin_bit_cast(bf16x8, w); } while (0)
    PK4(p0, 0, pa0); PK4(p0, 8, pa1); PK4(p1, 0, pa2); PK4(p1, 8, pa3);
#undef PK4
}
__device__ __forceinline__ void qkt128(f32x16& p0, f32x16& p1, LAS const char* Kt, int r32, int hi, const bf16x8* qr) {
    LAS const char* kb[4];
#pragma unroll
    for (int dd = 0; dd < 4; ++dd) kb[dd] = Kt + KSWZ(r32, (dd * 16 + hi * 8) * 2);
#pragma unroll
    for (int d0 = 0; d0 < 8; ++d0) { LAS const char* a = kb[d0 & 3] + (d0 >> 2) * 128;
        const bf16x8 b0 = *(LAS const bf16x8*)a, b1 = *(LAS const bf16x8*)(a + 32 * 256);
        p0 = __builtin_amdgcn_mfma_f32_32x32x16_bf16(b0, qr[d0], p0, 0, 0, 0);
        p1 = __builtin_amdgcn_mfma_f32_32x32x16_bf16(b1, qr[d0], p1, 0, 0, 0); }
}
__device__ __forceinline__ void qkt64(f32x16& p0, f32x16& p1, LAS const char* Kt, int r32, int hi, const bf16x8* qr) {
#pragma unroll
    for (int d0 = 0; d0 < 4; ++d0) { LAS const char* a = Kt + KSWZ64(r32, (d0 * 16 + hi * 8) * 2);
        const bf16x8 b0 = *(LAS const bf16x8*)a, b1 = *(LAS const bf16x8*)(a + 32 * 128);
        p0 = __builtin_amdgcn_mfma_f32_32x32x16_bf16(b0, qr[d0], p0, 0, 0, 0);
        p1 = __builtin_amdgcn_mfma_f32_32x32x16_bf16(b1, qr[d0], p1, 0, 0, 0); }
}
template <int ND0>
__device__ __forceinline__ void pv_tile(f32x16* o, int vb, bf16x8 pa0, bf16x8 pa1, bf16x8 pa2, bf16x8 pa3) {
    constexpr int KS = ND0 * 1024, HF = ND0 * 512;
#define TRRD(dst, off) asm volatile("ds_read_b64_tr_b16 %0, %1 offset:%2" : "=&v"(dst) : "v"(vb), "i"(off) : "memory")
#define PV_D0(d0) do { s16x4 l0, l1, l2, l3, h0, h1, h2, h3; constexpr int b_ = (d0) * 512; \
        TRRD(l0, b_); TRRD(h0, b_ + HF); TRRD(l1, b_ + KS); TRRD(h1, b_ + KS + HF); TRRD(l2, b_ + 2 * KS); TRRD(h2, b_ + 2 * KS + HF); TRRD(l3, b_ + 3 * KS); TRRD(h3, b_ + 3 * KS + HF); \
        asm volatile("s_waitcnt lgkmcnt(0)" ::: "memory"); SBAR(); \
        o[d0] = __builtin_amdgcn_mfma_f32_32x32x16_bf16(pa0, (bf16x8){l0[0], l0[1], l0[2], l0[3], h0[0], h0[1], h0[2], h0[3]}, o[d0], 0, 0, 0); \
        o[d0] = __builtin_amdgcn_mfma_f32_32x32x16_bf16(pa1, (bf16x8){l1[0], l1[1], l1[2], l1[3], h1[0], h1[1], h1[2], h1[3]}, o[d0], 0, 0, 0); \
        o[d0] = __builtin_amdgcn_mfma_f32_32x32x16_bf16(pa2, (bf16x8){l2[0], l2[1], l2[2], l2[3], h2[0], h2[1], h2[2], h2[3]}, o[d0], 0, 0, 0); \
        o[d0] = __builtin_amdgcn_mfma_f32_32x32x16_bf16(pa3, (bf16x8){l3[0], l3[1], l3[2], l3[3], h3[0], h3[1], h3[2], h3[3]}, o[d0], 0, 0, 0); } while (0)
    PV_D0(0); PV_D0(1);
    if constexpr (ND0 == 4) { PV_D0(2); PV_D0(3); }
#undef PV_D0
#undef TRRD
}
template <int ND0>
__device__ __forceinline__ void store_o(const f32x16* o, float l_reg, LAS float* li_l, bf16* Ow, int r32, int hi) {
    if (hi == 0) li_l[r32] = l_reg;
    LDS_WAIT();
    float rli[16];
#pragma unroll
    for (int r = 0; r < 16; ++r) rli[r] = __builtin_amdgcn_rcpf(li_l[crow(r, hi)]);
#pragma unroll
    for (int r = 0; r < 16; ++r) { const int orow = crow(r, hi);
#pragma unroll
        for (int d0 = 0; d0 < ND0; ++d0) { const float v = o[d0][r] * rli[r]; const float vn = shx<1>(v);
            if ((r32 & 1) == 0) *(unsigned*)(Ow + (size_t)orow * DM + d0 * 32 + r32) = cvt_pk_bf16(v, vn); } }
}
#define RESC(ND0) do { if (__any(alpha < 1.f)) { if (hi == 0) al_l[r32] = alpha; LDS_WAIT(); \
        _Pragma("unroll") for (int d_ = 0; d_ < (ND0); ++d_) _Pragma("unroll") for (int r = 0; r < 16; ++r) o[d_][r] *= al_l[crow(r, hi)]; } } while (0)

constexpr int A_V = 0, A_K = 32768, A_WS = 65536, A_KB = 67584, A_LUT = 68096, A_MISC = 74752;

template <int KIND>
__device__ __forceinline__ void attn128_unit(Frame& F, const Args& a, int l, int b, int h, int qb) {
    const int tid = opaque_v(F.tid_()), wid = __builtin_amdgcn_readfirstlane(tid >> 6), lane = tid & 63, r32 = lane & 31, hi = lane >> 5;
    LAS char* lds = (LAS char*)F.lds;
    LAS char* V_lds = lds + A_V; LAS char* K_lds = lds + A_K;
    LAS float* wsf = (LAS float*)(lds + A_WS) + wid * 64; LAS float* li_l = wsf; LAS float* al_l = wsf + 32;
    LAS float* kbuf = (LAS float*)(lds + A_KB);
    LAS float* lut = (LAS float*)(lds + A_LUT);
    LAS unsigned* bw = (LAS unsigned*)(lds + A_MISC);
    const bf16* PJ = (const bf16*)(F.ws + WS_PJ);
    const int q0 = qb * 256, qlo = q0 + wid * 32, qpos = qlo + r32;
    const size_t rowb = (size_t)b * SEQ;
    const bf16* Qp = PJ + (rowb + qpos) * LDP + (KIND == 0 ? PJ_BQ : PJ_AQ) + h * 128;
    const bf16* Kp = PJ + rowb * LDP + (KIND == 0 ? PJ_BK : PJ_AK) + h * 128;
    const bf16* Vp = PJ + rowb * LDP + (KIND == 0 ? PJ_BV : PJ_AV) + h * 128;
    const float* kbg = (const float*)(F.ws + WS_KB) + (size_t)(b * 4 + h) * SEQ;
    bf16x8 qr[8];
#pragma unroll
    for (int d0 = 0; d0 < 8; ++d0) qr[d0] = *(const bf16x8*)(Qp + d0 * 16 + hi * 8);
    const int sr = tid >> 4, sc = (tid & 15) * 8, vst0 = v_st<4>(sr, sc), vst1 = v_st<4>(32 + sr, sc), kws = KSWZ(sr, sc * 2);
    const int vb0 = (int)(unsigned)(size_t)V_lds + v_rd_base(lane);
    unsigned selmask = 0u; unsigned blkmask = 0u; float c31 = 0.f;
    if constexpr (KIND == 1) {
        const int own = qb;
        for (int i = tid; i < 1408; i += 512) { const int d = i - 128; lut[i] = d < 0 ? -__builtin_inff() : a.rel_bias[t5_bucket(d) * 12 + h] * LOG2E; }
        c31 = a.rel_bias[31 * 12 + h] * LOG2E;
        if (own > 0) {
            const float* km = (const float*)(F.ws + WS_CTL + CTL_KMEAN) + (size_t)l * 64 * 512 + (size_t)(b * 32 + sr) * 512 + h * 128 + sc;
            const f32x4 m0 = *(const f32x4*)km * (1.0f / 256.0f), m1 = *(const f32x4*)(km + 4) * (1.0f / 256.0f);
            u32x4 wh, wl; float e[8] = {m0.x, m0.y, m0.z, m0.w, m1.x, m1.y, m1.z, m1.w}; unsigned hh[8], ll[8];
#pragma unroll
            for (int k = 0; k < 8; ++k) { hh[k] = f2bf(e[k]); ll[k] = f2bf(e[k] - __builtin_bit_cast(float, hh[k] << 16)); }
            wh = (u32x4){hh[0] | (hh[1] << 16), hh[2] | (hh[3] << 16), hh[4] | (hh[5] << 16), hh[6] | (hh[7] << 16)};
            wl = (u32x4){ll[0] | (ll[1] << 16), ll[2] | (ll[3] << 16), ll[4] | (ll[5] << 16), ll[6] | (ll[7] << 16)};
            *(LAS u32x4*)(K_lds + kws) = wh; *(LAS u32x4*)(K_lds + kws + 32 * 256) = wl;
            __syncthreads();
            f32x16 s0 = {}, s1 = {};
            qkt128(s0, s1, K_lds, r32, hi, qr);
            float v1 = -__builtin_inff(), v2 = v1, v3 = v1; int i1 = 0, i2 = 0, i3 = 0;
#define INS(x, j) do { const float x_ = (x); const int j_ = (j); if (x_ > v1) { v3 = v2; i3 = i2; v2 = v1; i2 = i1; v1 = x_; i1 = j_; } else if (x_ > v2) { v3 = v2; i3 = i2; v2 = x_; i2 = j_; } else if (x_ > v3) { v3 = x_; i3 = j_; } } while (0)
#pragma unroll
            for (int r = 0; r < 16; ++r) { const int j = crow(r, hi); const float x = (j < own) ? (s0[r] + s1[r]) : -__builtin_inff(); INS(x, j); }
            const float w1 = shx<32>(v1), w2 = shx<32>(v2), w3 = shx<32>(v3);
            const int j1 = shx<32>(i1), j2 = shx<32>(i2), j3 = shx<32>(i3);
            INS(w1, j1); INS(w2, j2); INS(w3, j3);
#undef INS
            if (v1 > -__builtin_inff()) selmask |= 1u << i1;
            if (v2 > -__builtin_inff()) selmask |= 1u << i2;
            if (v3 > -__builtin_inff()) selmask |= 1u << i3;
            unsigned um = selmask;

            { um |= shx<1>(um); um |= shx<2>(um); um |= shx<4>(um); um |= shx<8>(um); um |= shx<16>(um); um |= shx<32>(um); }
            if (lane == 0) bw[wid] = um;
            __syncthreads();
            um = 0u;
#pragma unroll
            for (int w = 0; w < 8; ++w) um |= bw[w];
            blkmask = (unsigned)__builtin_amdgcn_readfirstlane((int)um);
        } else { __syncthreads(); }
        selmask |= 1u << own; blkmask |= 1u << own;
    }
    float m_reg = -1e30f, l_reg = 0.f, alpha; f32x16 o[4] = {};
    bf16x8 st_k0, st_k1, st_v0, st_v1; float st_kb = 0.f;
    float rowbound = 0.f; LAS unsigned* vote = bw + 16;
    if constexpr (KIND == 0) {
        float qq = 0.f;
#pragma unroll
        for (int d0 = 0; d0 < 8; ++d0) { const u32x4 w = __builtin_bit_cast(u32x4, qr[d0]);
            qq += (bf_lo(w.x) * bf_lo(w.x) + bf_hi(w.x) * bf_hi(w.x)) + (bf_lo(w.y) * bf_lo(w.y) + bf_hi(w.y) * bf_hi(w.y)) + (bf_lo(w.z) * bf_lo(w.z) + bf_hi(w.z) * bf_hi(w.z)) + (bf_lo(w.w) * bf_lo(w.w) + bf_hi(w.w) * bf_hi(w.w)); }
        qq += shx<32>(qq);
        const float kn2v = __uint_as_float(__hip_atomic_load((const unsigned*)(F.ws + WS_CTL) + CW_KN2 + (l * 8 + b * 4 + h) * 64, RLX_AGENT));
        rowbound = sqrtf(qq) * (2.0f * sqrtf(kn2v)) * 1.02f;
    }
#define LOADT(k0_) do { const bf16* kp_ = Kp + (size_t)((k0_) + sr) * LDP + sc; const bf16* vp_ = Vp + (size_t)((k0_) + sr) * LDP + sc; \
        st_k0 = *(const bf16x8*)kp_; st_k1 = *(const bf16x8*)(kp_ + (size_t)32 * LDP); st_v0 = *(const bf16x8*)vp_; st_v1 = *(const bf16x8*)(vp_ + (size_t)32 * LDP); \
        if (KIND == 0 && tid < 64) st_kb = kbg[(k0_) + tid]; } while (0)
#define WRITET(bf_) do { *(LAS bf16x8*)(K_lds + (bf_) * 16384 + kws) = st_k0; *(LAS bf16x8*)(K_lds + (bf_) * 16384 + kws + 32 * 256) = st_k1; \
        *(LAS bf16x8*)(V_lds + (bf_) * 16384 + vst0) = st_v0; *(LAS bf16x8*)(V_lds + (bf_) * 16384 + vst1) = st_v1; \
        if (KIND == 0 && tid < 64) kbuf[(bf_) * 64 + tid] = st_kb; } while (0)
    int k0; unsigned rem = 0u;
    if constexpr (KIND == 0) { k0 = q0 + 192; }
    else { rem = blkmask; const int jb = __builtin_ctz(rem); rem &= rem - 1u; k0 = jb * 256; }
    int buf = 0;
    LOADT(k0); WRITET(0);
    __syncthreads();
    for (;;) {
        int kn;
        if constexpr (KIND == 0) { kn = k0 - 64; }
        else { if ((k0 & 255) != 192) kn = k0 + 64; else if (rem) { const int jb = __builtin_ctz(rem); rem &= rem - 1u; kn = jb * 256; } else kn = -1; }
        if (kn >= 0) LOADT(kn);
        float kbprev = 0.f; if (KIND == 0 && k0 > 0) kbprev = kbg[k0 - 1];
        bool act = (k0 <= qlo + 31);
        bool sel = true;
        if constexpr (KIND == 1) { sel = (selmask >> (k0 >> 8)) & 1u; act = act && __any(sel); }
        if (act) {
            f32x16 p0, p1;
            if constexpr (KIND == 0) {
                LAS const float* kb_ = kbuf + buf * 64 + 4 * hi;
#pragma unroll
                for (int g = 0; g < 4; ++g) { const f32x4 x0 = *(LAS const f32x4*)(kb_ + 8 * g), x1 = *(LAS const f32x4*)(kb_ + 32 + 8 * g);
                    p0[4 * g] = x0.x; p0[4 * g + 1] = x0.y; p0[4 * g + 2] = x0.z; p0[4 * g + 3] = x0.w; p1[4 * g] = x1.x; p1[4 * g + 1] = x1.y; p1[4 * g + 2] = x1.z; p1[4 * g + 3] = x1.w; }
                if (k0 + 63 > qlo) {
                    const int dq = qpos - k0 - 4 * hi;
#pragma unroll
                    for (int r = 0; r < 16; ++r) { const int c = (r & 3) + 8 * (r >> 2); if (dq - c < 0) p0[r] = -__builtin_inff(); if (dq - c - 32 < 0) p1[r] = -__builtin_inff(); }
                }
            } else {
                const float NEG = -__builtin_inff();
                if (q0 - (k0 + 63) >= 790) {
                    const float v = sel ? c31 : NEG;
#pragma unroll
                    for (int r = 0; r < 16; ++r) { p0[r] = v; p1[r] = v; }
                } else {
                    LAS const float* lp = lut + 128 + (qpos - k0 - 4 * hi) - 63;
#pragma unroll
                    for (int r = 0; r < 16; ++r) { const int c = (r & 3) + 8 * (r >> 2); const float x0 = lp[63 - c], x1 = lp[31 - c]; p0[r] = sel ? x0 : NEG; p1[r] = sel ? x1 : NEG; }
                }
            }
            qkt128(p0, p1, K_lds + buf * 16384, r32, hi, qr);
            bf16x8 pa0, pa1, pa2, pa3;
            softmax_tile(p0, p1, m_reg, l_reg, alpha, pa0, pa1, pa2, pa3);
            RESC(4);
            pv_tile<4>(o, vb0 + buf * 16384, pa0, pa1, pa2, pa3);
        }
        if (kn >= 0) WRITET(buf ^ 1);
        if constexpr (KIND == 0) { const bool done = __all(rowbound + kbprev - m_reg < -40.0f); if (lane == 0) vote[buf * 8 + wid] = done ? 1u : 0u; }
        __syncthreads();
        if (kn < 0) break;
        if constexpr (KIND == 0) { unsigned v = 1u;
#pragma unroll
            for (int w = 0; w < 8; ++w) v &= vote[buf * 8 + w];
            if (__builtin_amdgcn_readfirstlane((int)v)) break; }
        k0 = kn; buf ^= 1;
    }
#undef LOADT
#undef WRITET
    bf16* Ow = (bf16*)(F.ws + WS_BR) + (rowb + qlo) * DM + (KIND == 0 ? 512 : 0) + h * 128 + 0;
    store_o<4>(o, l_reg, li_l, Ow, r32, hi);
    __syncthreads();
}

constexpr int M_LUT = 131584, M_BINS = 137216, M_SEL = 145408, M_CNT = 146432, M_TASK = 146560, M_NT = 146816, M_ML = 146832, M_WS = 155024;
static_assert(M_WS + 8 * 256 <= LDS_BYTES, "MoBA LDS map");
__device__ __forceinline__ void moba_unit(Frame& F, const Args& a, int l, int b, int h, int own) {
    const int tid = opaque_v(F.tid_()), wid = __builtin_amdgcn_readfirstlane(tid >> 6), lane = tid & 63, r32 = lane & 31, hi = lane >> 5;
    LAS char* lds = (LAS char*)F.lds;
    LAS float* lut = (LAS float*)(lds + M_LUT);
    LAS unsigned char* bins = (LAS unsigned char*)(lds + M_BINS);
    LAS unsigned* selw = (LAS unsigned*)(lds + M_SEL);
    LAS unsigned* cnt = (LAS unsigned*)(lds + M_CNT);
    LAS unsigned short* tasks = (LAS unsigned short*)(lds + M_TASK);
    LAS unsigned* ntp = (LAS unsigned*)(lds + M_NT);
    LAS f32x2* ml = (LAS f32x2*)(lds + M_ML);
    LAS float* al_l = (LAS float*)(lds + M_WS) + wid * 64; LAS int* qix = (LAS int*)(al_l + 32);
    LAS char* vreg = lds + wid * 16384;
    const bf16* PJ = (const bf16*)(F.ws + WS_PJ);
    const int q0 = own * 256; const size_t rowb = (size_t)b * SEQ;
    const bf16* Qb = PJ + (rowb + q0) * LDP + PJ_AQ + h * 128;
    const bf16* KFb = (const bf16*)(F.ws + WS_KF) + (size_t)(b * 4 + h) * 256 * 8 * 2 * 32 * 8;
    const bf16* VFb = (const bf16*)(F.ws + WS_VF) + (size_t)(b * 4 + h) * 512 * 4 * 2 * 32 * 8;
    bf16* part = (bf16*)(F.ws + WS_HY) + (size_t)bid_fresh() * (4 * 256 * 128);
    for (int i = tid; i < 1408; i += 512) { const int d = i - 128; lut[i] = d < 0 ? -__builtin_inff() : a.rel_bias[t5_bucket(d) * 12 + h] * LOG2E; }
    unsigned selmask = 0u;
    if (own > 0) {
        const int sr = tid >> 4, sc = (tid & 15) * 8, kws = KSWZ(sr, sc * 2);
        const float* km = (const float*)(F.ws + WS_CTL + CTL_KMEAN) + (size_t)l * 64 * 512 + (size_t)(b * 32 + sr) * 512 + h * 128 + sc;
        const f32x4 m0 = *(const f32x4*)km * (1.0f / 256.0f), m1 = *(const f32x4*)(km + 4) * (1.0f / 256.0f);
        float e[8] = {m0.x, m0.y, m0.z, m0.w, m1.x, m1.y, m1.z, m1.w}; unsigned hh[8], ll[8];
#pragma unroll
        for (int k = 0; k < 8; ++k) { hh[k] = f2bf(e[k]); ll[k] = f2bf(e[k] - __builtin_bit_cast(float, hh[k] << 16)); }
        *(LAS u32x4*)(lds + kws) = (u32x4){hh[0] | (hh[1] << 16), hh[2] | (hh[3] << 16), hh[4] | (hh[5] << 16), hh[6] | (hh[7] << 16)};
        *(LAS u32x4*)(lds + kws + 32 * 256) = (u32x4){ll[0] | (ll[1] << 16), ll[2] | (ll[3] << 16), ll[4] | (ll[5] << 16), ll[6] | (ll[7] << 16)};
        bf16x8 qn[8];
#pragma unroll
        for (int d0 = 0; d0 < 8; ++d0) qn[d0] = *(const bf16x8*)(Qb + (size_t)(wid * 32 + r32) * LDP + d0 * 16 + hi * 8);
        __syncthreads();
        f32x16 s0 = {}, s1 = {};
        qkt128(s0, s1, lds, r32, hi, qn);
        float v1 = -__builtin_inff(), v2 = v1, v3 = v1; int i1 = 0, i2 = 0, i3 = 0;
#define INS(x, j) do { const float x_ = (x); const int j_ = (j); if (x_ > v1) { v3 = v2; i3 = i2; v2 = v1; i2 = i1; v1 = x_; i1 = j_; } else if (x_ > v2) { v3 = v2; i3 = i2; v2 = x_; i2 = j_; } else if (x_ > v3) { v3 = x_; i3 = j_; } } while (0)
#pragma unroll
        for (int r = 0; r < 16; ++r) { const int j = crow(r, hi); const float x = (j < own) ? (s0[r] + s1[r]) : -__builtin_inff(); INS(x, j); }
        const float w1 = shx<32>(v1), w2 = shx<32>(v2), w3 = shx<32>(v3);
        const int j1 = shx<32>(i1), j2 = shx<32>(i2), j3 = shx<32>(i3);
        INS(w1, j1); INS(w2, j2); INS(w3, j3);
#undef INS
        if (v1 > -__builtin_inff()) selmask |= 1u << i1;
        if (v2 > -__builtin_inff()) selmask |= 1u << i2;
        if (v3 > -__builtin_inff()) selmask |= 1u << i3;
    }
    if (hi == 0) selw[wid * 32 + r32] = selmask;
    LAS unsigned char* wcnt = (LAS unsigned char*)(lds + M_TASK);
    for (int j = 0; j < own; ++j) { const unsigned long long bal = __ballot(hi == 0 && ((selmask >> j) & 1u)); if (lane == 0) wcnt[wid * 32 + j] = (unsigned char)__builtin_popcountll(bal); }
    __syncthreads();
    if (tid < 32) { unsigned c = 0; for (int w = 0; w < 8; ++w) c += wcnt[w * 32 + tid]; cnt[tid] = tid < own ? c : 0u; }
    for (int j = 0; j < own; ++j) { const bool mine = hi == 0 && ((selmask >> j) & 1u); const unsigned long long bal = __ballot(mine);
        if (mine) { unsigned pos = (unsigned)__builtin_popcountll(bal & ((1ull << lane) - 1ull)); for (int w = 0; w < wid; ++w) pos += wcnt[w * 32 + j]; bins[j * 256 + pos] = (unsigned char)(wid * 32 + r32); } }
    __syncthreads();
    if (tid == 0) { unsigned n = 0; for (int j = 0; j < own; ++j) { const unsigned c = (cnt[j] + 31u) >> 5; for (unsigned k = 0; k < c; ++k) tasks[n++] = (unsigned short)(j | (k << 8)); } ntp[0] = n; }
    __syncthreads();
    const int nt = (int)ntp[0];
    const int vb0 = (int)(unsigned)(size_t)vreg + v_rd_base(lane);
#pragma unroll 1
    for (int k = wid; k < nt + 8; k += 8) {
        int j, qi, slot, ktn; bool valid = true;
        if (k < nt) { const unsigned tk = tasks[k]; j = tk & 255; const int idx = (int)(tk >> 8) * 32 + r32; valid = idx < (int)cnt[j];
            qi = bins[j * 256 + (valid ? idx : 0)]; const unsigned sm = selw[qi]; slot = __builtin_popcount(sm & ((1u << j) - 1u)); ktn = 4; }
        else { const int g = k - nt; j = own; qi = g * 32 + r32; slot = 3; ktn = (g >> 1) + 1; }
        const int t = q0 + qi;
        bf16x8 qr[8];
#pragma unroll
        for (int d0 = 0; d0 < 8; ++d0) qr[d0] = *(const bf16x8*)(Qb + (size_t)qi * LDP + d0 * 16 + hi * 8);
        if (hi == 0) qix[r32] = valid ? (qi | (slot << 8)) : -1;
        float m_reg = -1e30f, l_reg = 0.f, alpha; f32x16 o[4] = {};
        const bf16* kpb = KFb + ((size_t)(j * 8) * 8 * 2 * 32 + hi * 32 + r32) * 8;
        const bf16* vpb = VFb + ((size_t)(j * 16) * 4 * 2 * 32 + hi * 32 + r32) * 8;
#pragma unroll 1
        for (int kt = 0; kt < ktn; ++kt) {
            const int k0 = j * 256 + kt * 64;
            const bf16* kp = kpb + (size_t)(kt * 2) * 8 * 512;
            const bf16* vp = vpb + (size_t)(kt * 4) * 4 * 512;
            bf16x8 kA0[4], kA1[4], kB0[4], kB1[4], vA[8], vB[8];
#pragma unroll
            for (int d = 0; d < 4; ++d) { kA0[d] = *(const bf16x8*)(kp + d * 512); kA1[d] = *(const bf16x8*)(kp + (8 + d) * 512); }
#pragma unroll
            for (int d = 0; d < 4; ++d) { kB0[d] = *(const bf16x8*)(kp + (4 + d) * 512); kB1[d] = *(const bf16x8*)(kp + (12 + d) * 512); }
#pragma unroll
            for (int i = 0; i < 8; ++i) vA[i] = *(const bf16x8*)(vp + i * 512);
            int dq = t - k0 - 4 * hi; dq = dq > 1100 ? 1100 : dq;
            LAS const float* lp = lut + 128 + dq - 63;
            f32x16 p0, p1;
#pragma unroll
            for (int r = 0; r < 16; ++r) { const int c = (r & 3) + 8 * (r >> 2); p0[r] = lp[63 - c]; p1[r] = lp[31 - c]; }
#pragma unroll
            for (int d = 0; d < 4; ++d) { p0 = __builtin_amdgcn_mfma_f32_32x32x16_bf16(kA0[d], qr[d], p0, 0, 0, 0); p1 = __builtin_amdgcn_mfma_f32_32x32x16_bf16(kA1[d], qr[d], p1, 0, 0, 0); }
#pragma unroll
            for (int d = 0; d < 4; ++d) { p0 = __builtin_amdgcn_mfma_f32_32x32x16_bf16(kB0[d], qr[4 + d], p0, 0, 0, 0); p1 = __builtin_amdgcn_mfma_f32_32x32x16_bf16(kB1[d], qr[4 + d], p1, 0, 0, 0); }
            asm volatile("" ::: "memory");
#pragma unroll
            for (int i = 0; i < 8; ++i) vB[i] = *(const bf16x8*)(vp + (8 + i) * 512);
            bf16x8 pa0, pa1, pa2, pa3;
            softmax_tile(p0, p1, m_reg, l_reg, alpha, pa0, pa1, pa2, pa3);
            if (__any(alpha < 1.f)) { if (hi == 0) al_l[r32] = alpha; LDS_WAIT();
#pragma unroll
                for (int d_ = 0; d_ < 4; ++d_)
#pragma unroll
                    for (int r = 0; r < 16; ++r) o[d_][r] *= al_l[crow(r, hi)]; }
#pragma unroll
            for (int d0 = 0; d0 < 4; ++d0) { o[d0] = __builtin_amdgcn_mfma_f32_32x32x16_bf16(pa0, vA[d0], o[d0], 0, 0, 0); o[d0] = __builtin_amdgcn_mfma_f32_32x32x16_bf16(pa1, vA[4 + d0], o[d0], 0, 0, 0); }
#pragma unroll
            for (int d0 = 0; d0 < 4; ++d0) { o[d0] = __builtin_amdgcn_mfma_f32_32x32x16_bf16(pa2, vB[d0], o[d0], 0, 0, 0); o[d0] = __builtin_amdgcn_mfma_f32_32x32x16_bf16(pa3, vB[4 + d0], o[d0], 0, 0, 0); }
        }
        if (hi == 0) { al_l[r32] = l_reg; if (valid) ml[slot * 256 + qi] = (f32x2){m_reg, l_reg}; }
        LDS_WAIT();
#pragma unroll
        for (int r = 0; r < 16; ++r) { const int rr = crow(r, hi); const int qrow = qix[rr]; const float rl = __builtin_amdgcn_rcpf(al_l[rr]);
            bf16* prow = part + ((size_t)(qrow < 0 ? 0 : (qrow >> 8)) * 256 + (qrow < 0 ? 0 : (qrow & 255))) * 128;
#pragma unroll
            for (int d0 = 0; d0 < 4; ++d0) { const float v = o[d0][r] * rl; const float vn = shx<1>(v);
                if ((r32 & 1) == 0 && qrow >= 0) *(unsigned*)(prow + d0 * 32 + r32) = cvt_pk_bf16(v, vn); } }
    }
    VM_WAIT();
    __syncthreads();
    __builtin_amdgcn_fence(__ATOMIC_ACQUIRE, "agent");
    { const int q = tid >> 1, hf = tid & 1; const unsigned sm = selw[q]; const int ns = __builtin_popcount(sm);
        float ms[4], ls[4]; float Mx = -1e30f;
#pragma unroll
        for (int s_ = 0; s_ < 4; ++s_) { const bool on = (s_ == 3) || (s_ < ns); const f32x2 v = on ? ml[s_ * 256 + q] : (f32x2){-1e30f, 0.f}; ms[s_] = v.x; ls[s_] = v.y; Mx = fmaxf(Mx, v.x); }
        float wsum = 0.f, wgt[4];
#pragma unroll
        for (int s_ = 0; s_ < 4; ++s_) { wgt[s_] = ls[s_] * __builtin_amdgcn_exp2f(ms[s_] - Mx); wsum += wgt[s_]; }
        const float rw = 1.0f / wsum;
        float accv[64];
#pragma unroll
        for (int i = 0; i < 64; ++i) accv[i] = 0.f;
#pragma unroll
        for (int s_ = 0; s_ < 4; ++s_) { if (wgt[s_] > 0.f) { const float w = wgt[s_] * rw; const u32x4* src = (const u32x4*)(part + ((size_t)s_ * 256 + q) * 128 + hf * 64);
#pragma unroll
                for (int c8 = 0; c8 < 8; ++c8) { const u32x4 x = src[c8];
                    accv[c8 * 8 + 0] += w * bf_lo(x.x); accv[c8 * 8 + 1] += w * bf_hi(x.x); accv[c8 * 8 + 2] += w * bf_lo(x.y); accv[c8 * 8 + 3] += w * bf_hi(x.y);
                    accv[c8 * 8 + 4] += w * bf_lo(x.z); accv[c8 * 8 + 5] += w * bf_hi(x.z); accv[c8 * 8 + 6] += w * bf_lo(x.w); accv[c8 * 8 + 7] += w * bf_hi(x.w); } } }
        u32x4* dst = (u32x4*)((bf16*)(F.ws + WS_BR) + (rowb + q0 + q) * DM + h * 128 + hf * 64);
#pragma unroll
        for (int c8 = 0; c8 < 8; ++c8) { u32x4 o4; o4.x = cvt_pk_bf16(accv[c8 * 8 + 0], accv[c8 * 8 + 1]); o4.y = cvt_pk_bf16(accv[c8 * 8 + 2], accv[c8 * 8 + 3]);
            o4.z = cvt_pk_bf16(accv[c8 * 8 + 4], accv[c8 * 8 + 5]); o4.w = cvt_pk_bf16(accv[c8 * 8 + 6], accv[c8 * 8 + 7]); dst[c8] = o4; } }
    __syncthreads();
}

__device__ __forceinline__ void swa_unit(Frame& F, const Args& a, int l, int b, int kvh, int nb) {
    const int tid = opaque_v(F.tid_()), wid = __builtin_amdgcn_readfirstlane(tid >> 6), lane = tid & 63, r32 = lane & 31, hi = lane >> 5;
    LAS char* lds = (LAS char*)F.lds;
    LAS char* V_lds = lds + A_V; LAS char* K_lds = lds + A_K;
    LAS float* wsf = (LAS float*)(lds + A_WS) + wid * 64; LAS float* li_l = wsf; LAS float* al_l = wsf + 32;
    LAS float* lut = (LAS float*)(lds + A_LUT);
    const bf16* PJ = (const bf16*)(F.ws + WS_PJ);
    const int T0 = nb * 128; const size_t rowb = (size_t)b * SEQ;
    const int g = wid >> 1, half = wid & 1, head = kvh * 4 + g;
    for (int i = tid; i < 4 * 384; i += 512) { const int gg = i / 384, d = (i % 384) - 128;
        lut[i] = (d < 0 || d >= 128) ? -__builtin_inff() : a.rel_bias[t5_bucket(d) * 12 + 4 + kvh * 4 + gg] * LOG2E; }
    { const int sr = tid >> 3, sc = (tid & 7) * 8;
#pragma unroll
      for (int kt = 0; kt < 4; ++kt) { const int k0 = T0 - 128 + 64 * kt; if (k0 < 0) continue;
          const bf16* kp = PJ + (rowb + k0 + sr) * LDP + PJ_DK + kvh * 64 + sc; const bf16* vp = PJ + (rowb + k0 + sr) * LDP + PJ_DV + kvh * 64 + sc;
          const bf16x8 kk = *(const bf16x8*)kp, vv = *(const bf16x8*)vp;
          *(LAS bf16x8*)(K_lds + kt * 8192 + KSWZ64(sr, sc * 2)) = kk; *(LAS bf16x8*)(V_lds + kt * 8192 + v_st<2>(sr, sc)) = vv; } }
    __syncthreads();
    const float sinkv = a.sinks[l * 8 + head] * LOG2E;
    const int vb0 = (int)(unsigned)(size_t)V_lds + v_rd_base(lane);
#pragma unroll 1
    for (int qg = 0; qg < 2; ++qg) {
        const int r0 = T0 + 64 * half + 32 * qg, qpos = r0 + r32;
        const bf16* Qp = PJ + (rowb + qpos) * LDP + PJ_DQ + head * 64;
        bf16x8 qr[4];
#pragma unroll
        for (int d0 = 0; d0 < 4; ++d0) qr[d0] = *(const bf16x8*)(Qp + d0 * 16 + hi * 8);
        float m_reg = sinkv, l_reg = 1.0f, alpha; f32x16 o[2] = {};
#pragma unroll 1
        for (int kt = 0; kt < 4; ++kt) { const int k0 = T0 - 128 + 64 * kt;
            if (k0 < 0 || k0 > r0 + 31 || k0 + 63 < r0 - 127) continue;
            LAS const float* lp = lut + g * 384 + 128 + (qpos - k0 - 4 * hi) - 63;
            f32x16 p0, p1;
#pragma unroll
            for (int r = 0; r < 16; ++r) { const int c = (r & 3) + 8 * (r >> 2); p0[r] = lp[63 - c]; p1[r] = lp[31 - c]; }
            qkt64(p0, p1, K_lds + kt * 8192, r32, hi, qr);
            bf16x8 pa0, pa1, pa2, pa3;
            softmax_tile(p0, p1, m_reg, l_reg, alpha, pa0, pa1, pa2, pa3);
            RESC(2);
            pv_tile<2>(o, vb0 + kt * 8192, pa0, pa1, pa2, pa3);
        }
        bf16* Ow = (bf16*)(F.ws + WS_BR) + (rowb + r0) * DM + 1536 + head * 64;
        store_o<2>(o, l_reg, li_l, Ow, r32, hi);
    }
    __syncthreads();
}
#undef RESC
}

__device__ __forceinline__ void conv_unit(Frame& F, const Args& a, int l, int cu) {
    const int c = opaque_v(F.tid_()), lane = c & 63, wave = __builtin_amdgcn_readfirstlane(c >> 6); const int m0 = cu * 32, t0 = m0 % SEQ;
    const bf16* PJ = (const bf16*)(F.ws + WS_PJ);
    LAS float* cv = (LAS float*)F.lds;
    float w[31];
#pragma unroll
    for (int j = 0; j < 31; ++j) w[j] = a.conv_w[(size_t)l * 31 * 512 + j * 512 + c];
    const float cb = a.conv_b[l * 512 + c];
    float in[62];
#pragma unroll
    for (int i = 0; i < 62; ++i) { const int t = t0 - 30 + i; in[i] = t >= 0 ? __builtin_bit_cast(float, (unsigned)PJ[(size_t)(m0 - 30 + i) * LDP + PJ_GLU + c] << 16) : 0.f; }
#pragma unroll
    for (int t = 0; t < 32; ++t) { float s = cb;
#pragma unroll
        for (int j = 0; j < 31; ++j) s += w[j] * in[t + j];
        cv[t * 512 + c] = s; }
    __syncthreads();
    const float* lg = a.conv_g + l * 512; const float* lb = a.conv_beta + l * 512;
    bf16* BR = (bf16*)(F.ws + WS_BR);
#pragma unroll 1
    for (int rr = 0; rr < 4; ++rr) { const int t = wave * 4 + rr;
        const f32x4 v0 = *(LAS const f32x4*)(cv + t * 512 + 8 * lane), v1 = *(LAS const f32x4*)(cv + t * 512 + 8 * lane + 4);
        float s = (v0.x + v0.y) + (v0.z + v0.w) + (v1.x + v1.y) + (v1.z + v1.w);
        const float mu = wave_sum(s) * (1.0f / 512.0f);
        const f32x4 d0 = v0 - mu, d1 = v1 - mu;
        float q = (d0.x * d0.x + d0.y * d0.y) + (d0.z * d0.z + d0.w * d0.w) + (d1.x * d1.x + d1.y * d1.y) + (d1.z * d1.z + d1.w * d1.w);
        const float rs = 1.0f / sqrtf(wave_sum(q) * (1.0f / 512.0f) + LN_EPS);
        const f32x4 g0 = *(const f32x4*)(lg + 8 * lane), g1 = *(const f32x4*)(lg + 8 * lane + 4), b0 = *(const f32x4*)(lb + 8 * lane), b1 = *(const f32x4*)(lb + 8 * lane + 4);
        f32x4 y0 = d0 * rs * g0 + b0, y1 = d1 * rs * g1 + b1;
#pragma unroll
        for (int k = 0; k < 4; ++k) { y0[k] = y0[k] * fsigmoid(y0[k]); y1[k] = y1[k] * fsigmoid(y1[k]); }
        u32x4 o; o.x = pk2(y0.x, y0.y); o.y = pk2(y0.z, y0.w); o.z = pk2(y1.x, y1.y); o.w = pk2(y1.z, y1.w);
        *(u32x4*)(BR + (size_t)(m0 + t) * DM + 1024 + 8 * lane) = o; }
    __syncthreads();
}

constexpr int NU_ATTQ = 64, NU_SWA = 256, NU_CONV = 512, NU_REST = NU_SWA + NU_CONV;
__device__ __forceinline__ void mixer_phase(Frame& F, const Args& a, int l) {
    gu32* heads = F.ctl + CW_QUEUE + 64 * 16 * l;
    LAS unsigned* slot = (LAS unsigned*)(F.lds + RING_BYTES + 128);
    const int x = (int)(xb_xcc_id() & 7u);
    for (int s = 0; s < 8; ++s) {
        const int qq = (x + s) & 7;
        for (;;) {
            if (F.tid_() == 0) slot[0] = __hip_atomic_fetch_add(heads + 64 * qq, 1u, RLX_AGENT);
            __syncthreads();
            const int idx = (int)slot[0];
            __syncthreads();
            if (idx >= NU_ATTQ) break;
            const int qb = 31 - (idx >> 1), kind = idx & 1;
            if (kind == 1) { if (PH_EN(9)) att::moba_unit(F, a, l, qq >> 2, qq & 3, qb); } else { if (PH_EN(8)) att::attn128_unit<0>(F, a, l, qq >> 2, qq & 3, qb); }
        }
    }
    for (;;) {
        if (F.tid_() == 0) slot[0] = __hip_atomic_fetch_add(heads + 64 * 8, 1u, RLX_AGENT);
        __syncthreads();
        const int idx = (int)slot[0];
        __syncthreads();
        if (idx >= NU_REST) break;
        if (idx < NU_SWA) { if (PH_EN(10)) att::swa_unit(F, a, l, idx >> 7, (idx >> 6) & 1, idx & 63); }
        else { if (PH_EN(11)) conv_unit(F, a, l, idx - NU_SWA); }
    }
}

constexpr int NPHASE = 1 + 8 * DEPTH + 1;
__global__ void __launch_bounds__(512, 2) fwd(Args args) {
    extern __shared__ __attribute__((aligned(16))) unsigned char lds_raw[];
    Frame F;
    F.lds = (LAS unsigned char*)lds_raw; F.MISC = (volatile LAS unsigned*)(F.lds + MISC_OFF);
    F.wave = __builtin_amdgcn_readfirstlane((int)threadIdx.x >> 6); F.G = gridDim.x;
    F.ws = args.ws; F.ctl = (gu32*)(args.ws + WS_CTL);
    for (int u = F.tid_(); u < (LDS_BYTES - RING_BYTES) / 4; u += 512) ((LAS unsigned*)(F.lds + RING_BYTES))[u] = 0u;
    __syncthreads();
    XcdBarrier bar; bar.bar = (unsigned*)(F.ctl + CW_BAR); bar.x = 0; bar.st = nullptr; bar.wave = F.wave;
    const bool one_launch = (args.ph_hi - args.ph_lo) > 1;
    if (one_launch) bar = xcd_barrier_post((unsigned*)(F.ctl + CW_BAR), F.MISC + 8, F.wave);
    const int lo = args.ph_lo, hi = args.ph_hi;
#define IN(k) (lo <= (k) && (k) < hi)
#define SEAM(k) do { if (IN(k) && IN((k) + 1)) xcd_barrier(bar); } while (0)
    float* MOD = (float*)(args.ws + WS_MOD);
    bf16* HY = (bf16*)(args.ws + WS_HY); bf16* PJb = (bf16*)(args.ws + WS_PJ); bf16* GT = (bf16*)(args.ws + WS_GT);
    bf16* BR = (bf16*)(args.ws + WS_BR); bf16* YO = BR; bf16* MID = GT;

#ifdef DBG_STOP
    if (lo >= 100) {
        const int code = lo - 100; const bf16* src; int pitch;
        if (code == 0) { src = HY; pitch = DM; } else if (code == 1) { src = PJb; pitch = LDP; } else if (code == 2) { src = GT; pitch = 8192; } else if (code == 3) { src = BR; pitch = DM; }
        else if (code == 4) { src = MID; pitch = DFF; } else if (code == 5) { src = PJb + 2304; pitch = LDP; } else if (code == 6) { src = GT + 6144; pitch = 8192; } else { src = MID + 3584; pitch = DFF; }
        for (size_t i = (size_t)bid_fresh() * 512 + F.tid_(); i < (size_t)M * DM; i += (size_t)F.G * 512) { const size_t r = i / DM, c = i % DM; args.out[i] = __builtin_bit_cast(float, (unsigned)src[r * pitch + c] << 16); }
        return;
    }
#endif
    if (PH_EN(0) && IN(0)) { p0_prologue(F, args); } SEAM(0);

#pragma unroll 1
    for (int l = 0; l < DEPTH; ++l) {
        const int pb = 1 + 8 * l;
        unsigned char* wl = args.ws + WS_W + (size_t)l * W_LAYER;
        const float* modl = MOD + (size_t)l * 2 * 12288;
        if (l == 0) {
            if (PH_EN(1) && IN(pb)) { if (bid_fresh() == 0) h2_scales(F, args);
                NormArgs n{}; n.xin = args.x; n.hout = nullptr; n.lf = (float*)(args.ws + WS_LF);
                n.nx_gain = args.mix_pre; n.nx_scale = modl + 2048; n.nx_shift = modl; n.wf = args.w_in; n.fox_b = args.fox_bias; n.flags = 2 | 4; n.h8 = (unsigned char*)YO; n.hr = (float*)(args.ws + WS_HR);
                norm_phase(F, n); }
        }
        SEAM(pb);
        if (PH_EN(2) && IN(pb + 1)) {
            if (bid_fresh() >= 192 && bid_fresh() < 200) fox_scan(F, bid_fresh() - 192);
#ifdef DBG_FILL
            { const u32x4* src = (const u32x4*)(HY + (size_t)bid_fresh() * 64 * DM); u32x4* dst = (u32x4*)(BR + (size_t)bid_fresh() * 64 * DM);
              for (int i = F.tid_(); i < 64 * DM / 8; i += 512) dst[i] = src[i]; }
#endif
            { typedef pg8::Dims<DM, DM / 2, DM / 2, 64, 19, 1, 0, 0> D;
              pg8::Gemm g{(const bf16*)YO, (const bf16*)(wl + W_IN)};
              pg8::TileOrder<D> S{F.G, (int)bid_fresh()};
              pg8::EpiProj E{PJb, GT, (bf16*)(args.ws + WS_KF), (bf16*)(args.ws + WS_VF), (float*)(args.ws + WS_CTL + CTL_KMEAN) + (size_t)l * 64 * 512, (unsigned*)(args.ws + WS_CTL) + CW_KN2 + l * 8 * 64,
                               (const float*)(args.ws + WS_HR), (const float*)(args.ws + WS_SG) + (size_t)l * 13056};
              pg8::gemm_phase<D>(F.lds, g, S, E, F.wave); }
            __syncthreads();
            { typedef pg8::Dims<DM, DM / 2, DM / 2, 64, 32, 1, 0, 0> D;
              pg8::Gemm g{(const bf16*)YO, (const bf16*)(wl + W_IN + (size_t)(19 * 256) * DM)};
              pg8::TileOrder<D> S{F.G, (int)bid_fresh()};
              pg8::EpiGate8 E{GT, (const float*)(args.ws + WS_HR), (const float*)(args.ws + WS_SG) + (size_t)l * 13056 + 19 * 256};
              pg8::gemm_phase<D>(F.lds, g, S, E, F.wave); }
        }
        SEAM(pb + 1);
        if (PH_EN(3) && IN(pb + 2)) mixer_phase(F, args, l);
        SEAM(pb + 2);
        if (PH_EN(4) && IN(pb + 3)) {
            typedef pg8::Dims<DM, DM, DM, 64, 8, 1, 0, 0> D;
            pg8::Gemm g{BR, (const bf16*)(wl + W_BR)};
            pg8::TileOrder<D> S{F.G, (int)bid_fresh()};
            pg8::EpiMerge E{(const unsigned char*)GT, HY};
            pg8::gemm_phase<D>(F.lds, g, S, E, F.wave);
        }
        SEAM(pb + 3);
        if (PH_EN(5) && IN(pb + 4)) {
            typedef pg8::Dims<DM, DM, DM, 64, 8, 1, 0, 0> D;
            pg8::Gemm g{HY, (const bf16*)(wl + W_OUT)};
            float* xs = (float*)(args.ws + WS_XS); gu32* xc = F.ctl + (CTL_XCNT / 4);
            pg8::EpiResNorm E{};
            if (l == 0) { E.xf32 = args.x; E.xo = (bf16*)args.out; E.xo_pitch = 2 * DM; E.xo_off = DM; }
            else { E.xb = (const bf16*)args.out; E.xb_pitch = 2 * DM; E.xb_off = DM; E.xo = YO; E.xo_pitch = DM; E.xo_off = 0; }
            E.res_gate = modl + 4096; E.res_gain = args.mix_post + l * DM;
            E.hout = PJb; E.nx_gain = args.ffn_pre + l * DM; E.nx_scale = modl + 8192; E.nx_shift = modl + 6144; E.hs = (const float*)(args.ws + WS_HS) + l * 2;
            E.ex1 = pg8::RowX{xs + (size_t)(l * 4 + 0) * 64 * 256 * 8, xc + (l * 4 + 0) * 64 * 16, F.ctl + 2};
            E.ex2 = pg8::RowX{xs + (size_t)(l * 4 + 1) * 64 * 256 * 8, xc + (l * 4 + 1) * 64 * 16, F.ctl + 2};
#pragma unroll 1
            for (int sl = 0; sl < 2; ++sl) { pg8::SliceOrder<D> S{sl, (int)bid_fresh()}; pg8::gemm_phase<D>(F.lds, g, S, E, F.wave); __syncthreads(); }
        }
        SEAM(pb + 4);
        if (PH_EN(6) && IN(pb + 6)) {
            typedef pg8::Dims<DM / 2, DM / 2, DM / 2, 64, 44, 1, 0, 0> D;
            pg8::Gemm g{PJb, (const bf16*)(wl + W_GU)};
            pg8::TileOrder<D> S{F.G, (int)bid_fresh()};
            pg8::EpiSwiGLU E{MID, DFF, (const float*)(args.ws + WS_SW) + (size_t)l * 2 * DFF, (const float*)(args.ws + WS_HS) + l * 2};
            pg8::gemm_phase<D>(F.lds, g, S, E, F.wave);
        }
        SEAM(pb + 6);
        if (PH_EN(7) && IN(pb + 7)) {
            typedef pg8::Dims<64, DFF, DFF, 64, 8, 1, 0, 0, 32768, (long)DFF * 256 * 2> D;
            pg8::Gemm g{MID, (const bf16*)(wl + W_DN)};
            if (l + 1 < DEPTH) {
                pg8::TileOrder<D> S{F.G, (int)bid_fresh()};
                pg8::EpiBf16 E{YO, DM};
                pg8::gemm_phase<D>(F.lds, g, S, E, F.wave);
            } else {
                float* xs = (float*)(args.ws + WS_XS); gu32* xc = F.ctl + (CTL_XCNT / 4);
                pg8::EpiResNorm E{};
                E.xb = YO; E.xb_pitch = DM; E.xb_off = 0; E.outf = args.out;
                E.res_gate = modl + 10240; E.res_gain = args.ffn_post + l * DM;
                E.ex1 = pg8::RowX{xs + (size_t)(l * 4 + 2) * 64 * 256 * 8, xc + (l * 4 + 2) * 64 * 16, F.ctl + 2};
#pragma unroll 1
                for (int sl = 0; sl < 2; ++sl) { pg8::SliceOrder<D> S{sl, (int)bid_fresh()}; pg8::gemm_phase<D>(F.lds, g, S, E, F.wave); __syncthreads(); }
            }
        }
        if (l + 1 < DEPTH) {
        SEAM(pb + 7);
        if (PH_EN(1) && IN(pb + 8)) { NormArgs n{}; n.xin = args.out; n.xout = args.out; n.yo = YO; n.hout = nullptr; n.lf = (float*)(args.ws + WS_LF);
            n.res_gate = modl + 10240; n.res_gain = args.ffn_post + l * DM;
            const float* modn = MOD + (size_t)(l + 1) * 2 * 12288;
            n.nx_gain = args.mix_pre + (l + 1) * DM; n.nx_scale = modn + 2048; n.nx_shift = modn; n.wf = args.w_in + (size_t)(l + 1) * DM * INW; n.fox_b = args.fox_bias + (l + 1) * 4; n.flags = 1 | 2 | 4 | 8 | 16; n.h8 = (unsigned char*)YO; n.hr = (float*)(args.ws + WS_HR);
            norm_phase(F, n); }
        }
    }
#undef IN
#undef SEAM
}

extern "C" void kernel_launch(void* const* d_in, const int* in_sizes, int n_in, void* d_out, int out_size, void* d_ws, size_t ws_size, hipStream_t stream) {
    static int grid = 0;
    if (grid == 0) {
        if (n_in != 24 || in_sizes[0] != M * DM || out_size != M * DM || ws_size < WS_END) {
            fprintf(stderr, "kernel_launch: unexpected shapes (n_in %d, in0 %d, out %d, ws %zu < %zu?)\n", n_in, n_in > 0 ? in_sizes[0] : -1, out_size, ws_size, (size_t)WS_END); grid = -1; return; }
        int dev = 0, cus = 0, per_cu = 0;
        if (hipGetDevice(&dev) != hipSuccess || hipDeviceGetAttribute(&cus, hipDeviceAttributeMultiprocessorCount, dev) != hipSuccess) { grid = -1; return; }
        if (hipFuncSetAttribute((const void*)fwd, hipFuncAttributeMaxDynamicSharedMemorySize, LDS_BYTES) != hipSuccess) { fprintf(stderr, "kernel_launch: hipFuncSetAttribute failed\n"); grid = -1; return; }
        if (hipOccupancyMaxActiveBlocksPerMultiprocessor(&per_cu, (const void*)fwd, 512, LDS_BYTES) != hipSuccess || per_cu < 1) { fprintf(stderr, "kernel_launch: occupancy query says %d\n", per_cu); }
        (void)hipGetLastError();
        grid = cus;
        if (grid != 256) { fprintf(stderr, "kernel_launch: the fused epilogues assume 256 CUs, found %d\n", grid); grid = -1; return; }
    }
    if (grid < 0) return;
    if (hipMemsetAsync((char*)d_ws + WS_CTL, 0, CTL_ZERO_BYTES, stream) != hipSuccess) return;
    Args a{};
    const float** ap = (const float**)&a;
    for (int i = 0; i < 24; ++i) ap[i] = (const float*)d_in[i];
    a.out = (float*)d_out; a.ws = (unsigned char*)d_ws;
#if defined(DBG_STOP)
    for (int p = 0; p <= DBG_STOP; ++p) { a.ph_lo = p; a.ph_hi = p + 1; hipLaunchKernelGGL(fwd, dim3(grid), dim3(512), LDS_BYTES, stream, a); }
    a.ph_lo = 100 + DBG_SRC; a.ph_hi = 101 + DBG_SRC; hipLaunchKernelGGL(fwd, dim3(grid), dim3(512), LDS_BYTES, stream, a);
#elif MK_PER_PHASE
    for (int p = 0; p < NPHASE; ++p) {
        a.ph_lo = p; a.ph_hi = p + 1;
        hipLaunchKernelGGL(fwd, dim3(grid), dim3(512), LDS_BYTES, stream, a);
    }
#else
    a.ph_lo = 0; a.ph_hi = NPHASE;
    hipLaunchKernelGGL(fwd, dim3(grid), dim3(512), LDS_BYTES, stream, a);
#endif
}
```

```cpp
#include <hip/hip_runtime.h>
#include <cstdio>
#include <cstdint>

#ifndef MK_PER_PHASE
#define MK_PER_PHASE 0
#endif

#ifndef PH_MASK
#define PH_MASK 0xFFFF
#endif
#define PH_EN(k) (((PH_MASK) >> (k)) & 1)
#define GAS __attribute__((address_space(1)))
#define LAS __attribute__((address_space(3)))
typedef unsigned short bf16;
typedef short bf16x8 __attribute__((ext_vector_type(8)));
typedef short s16x4 __attribute__((ext_vector_type(4)));
typedef float f32x4 __attribute__((ext_vector_type(4)));
typedef float f32x2 __attribute__((ext_vector_type(2)));
typedef float f32x16 __attribute__((ext_vector_type(16)));
typedef unsigned u32x4 __attribute__((ext_vector_type(4)));
typedef unsigned u32x2 __attribute__((ext_vector_type(2)));
typedef GAS unsigned gu32;

constexpr int DM = 2048, NBATCH = 2, SEQ = 8192, M = NBATCH * SEQ, DEPTH = 2;
constexpr int DFF = 5632, INW = 13060, INWP = 13056;
constexpr int LDP = 4352;
constexpr int PJ_AQ = 0, PJ_AK = 512, PJ_AV = 1024, PJ_BQ = 1536, PJ_BK = 2048, PJ_BV = 2560, PJ_GLU = 3072, PJ_DQ = 3584, PJ_DK = 4096, PJ_DV = 4224;
constexpr float RMS_EPS = 1e-6f, LN_EPS = 1e-5f, LOG2E = 1.4426950408889634f;
constexpr float C2_128 = 0.08838834764831845f * LOG2E, C2_64 = 0.125f * LOG2E;

constexpr size_t MiB = 1u << 20;
constexpr size_t WS_CTL = 0, CTL_ZERO_BYTES = 1 * MiB;
constexpr size_t WS_MOD = 1 * MiB;
constexpr size_t WS_LF = 1 * MiB + 256 * 1024;
constexpr size_t WS_KB = 1 * MiB + 512 * 1024;
constexpr size_t WS_W = 2 * MiB;
constexpr size_t W_IN = 0, W_BR = 51 * MiB, W_OUT = 59 * MiB, W_GU = 67 * MiB, W_DN = 111 * MiB, W_LAYER = 133 * MiB;
constexpr size_t W_IN8 = W_IN + (size_t)(19 * 256) * DM * 2;
constexpr size_t WS_HY = 268 * MiB;
constexpr size_t WS_PJ = 332 * MiB;
constexpr size_t WS_GT = 468 * MiB;
constexpr size_t WS_BR = 724 * MiB;
constexpr size_t WS_KF = 788 * MiB;
constexpr size_t WS_VF = 804 * MiB;
constexpr size_t WS_XS = 820 * MiB;
constexpr size_t WS_SW = 824 * MiB;
constexpr size_t WS_HS = WS_SW + 96 * 1024;
constexpr size_t WS_HR = WS_SW + 128 * 1024;
constexpr size_t WS_SG = WS_SW + 192 * 1024;
constexpr size_t WS_END = 825 * MiB;
constexpr int CW_BAR = 4096;
constexpr int CW_QUEUE = 8192;
constexpr int CW_KN2 = 12288;
constexpr size_t CTL_XCNT = 128 * 1024;
constexpr size_t CTL_KMEAN = 512 * 1024;

constexpr int RING_BYTES = 131072;
constexpr int MISC_OFF = RING_BYTES + 320;
constexpr int LDS_BYTES = 163840;

#define LDS_WAIT() asm volatile("s_waitcnt lgkmcnt(0)" ::: "memory")
#define VM_WAIT() asm volatile("s_waitcnt vmcnt(0)" ::: "memory")
#define RLX_AGENT __ATOMIC_RELAXED, __HIP_MEMORY_SCOPE_AGENT

typedef __bf16 bf16x2_t __attribute__((ext_vector_type(2)));
__device__ __forceinline__ unsigned cvt_pk_bf16(float lo, float hi) { const f32x2 v = {lo, hi}; const bf16x2_t b = __builtin_convertvector(v, bf16x2_t); return __builtin_bit_cast(unsigned, b); }
__device__ __forceinline__ unsigned f2bf(float f) { unsigned u = __builtin_bit_cast(unsigned, f); return (u + 0x7fffu + ((u >> 16) & 1u)) >> 16; }
__device__ __forceinline__ unsigned pk2(float lo, float hi) { return f2bf(lo) | (f2bf(hi) << 16); }
__device__ __forceinline__ float bf_lo(unsigned w) { return __builtin_bit_cast(float, w << 16); }
__device__ __forceinline__ float bf_hi(unsigned w) { return __builtin_bit_cast(float, w & 0xffff0000u); }
__device__ __forceinline__ float fsigmoid(float x) { return __builtin_amdgcn_rcpf(1.0f + __builtin_amdgcn_exp2f(-x * LOG2E)); }
__device__ __forceinline__ unsigned pk4_i8(float a, float b, float c, float d) {
    const int ia = (int)__builtin_rintf(__builtin_fminf(__builtin_fmaxf(a, -127.f), 127.f)), ib = (int)__builtin_rintf(__builtin_fminf(__builtin_fmaxf(b, -127.f), 127.f));
    const int ic = (int)__builtin_rintf(__builtin_fminf(__builtin_fmaxf(c, -127.f), 127.f)), id = (int)__builtin_rintf(__builtin_fminf(__builtin_fmaxf(d, -127.f), 127.f));
    return (unsigned)(ia & 255) | ((unsigned)(ib & 255) << 8) | ((unsigned)(ic & 255) << 16) | ((unsigned)id << 24);
}
__device__ __forceinline__ unsigned pk4_fp8(float a, float b, float c, float d) { int w = 0; w = __builtin_amdgcn_cvt_pk_fp8_f32(a, b, w, false); w = __builtin_amdgcn_cvt_pk_fp8_f32(c, d, w, true); return (unsigned)w; }
__device__ __forceinline__ int opaque_v(int v) { asm volatile("" : "+v"(v)); return v; }
__device__ __forceinline__ int lane_id_fresh() { int l; asm volatile("v_mbcnt_lo_u32_b32 %0, -1, 0\n\tv_mbcnt_hi_u32_b32 %0, -1, %0" : "=v"(l)); return l; }
template <int M> __device__ __forceinline__ int shx(int v) {
    if constexpr (M < 32) return __builtin_amdgcn_ds_swizzle(v, (M << 10) | 0x1f);
    else return __builtin_amdgcn_ds_bpermute((lane_id_fresh() ^ M) << 2, v);
}
template <int M> __device__ __forceinline__ float shx(float v) { return __builtin_bit_cast(float, shx<M>(__builtin_bit_cast(int, v))); }
template <int M> __device__ __forceinline__ unsigned shx(unsigned v) { return (unsigned)shx<M>((int)v); }
template <int O> __device__ __forceinline__ float shup(float v, int lane) { return __builtin_bit_cast(float, __builtin_amdgcn_ds_bpermute((lane - O) << 2, __builtin_bit_cast(int, v))); }
__device__ __forceinline__ unsigned bid_fresh() { unsigned v = blockIdx.x; asm volatile("" : "+s"(v)); return v; }
__device__ __forceinline__ float wave_sum(float v) {
    v += shx<1>(v); v += shx<2>(v); v += shx<4>(v); v += shx<8>(v); v += shx<16>(v); v += shx<32>(v);
    return v;
}

namespace pg8 {
typedef unsigned short bf16_t;
constexpr int BM = 256, BK = 64, HALF = 128, HTB = HALF * BK * 2, STAGE_BYTES = 8 * HTB, NXCD = 8, WGM = 8;
__host__ __device__ __forceinline__ int lds_byte(int r, int c) { const int st = (r >> 4) * 2 + (c >> 5), rr = r & 15, cc = c & 31, ob = rr * 64 + cc * 2; return st * 1024 + (ob ^ (((ob >> 9) & 1) << 5)); }
__host__ __device__ __forceinline__ void stage_rc(int b, int& R, int& C) { const int st = b / 1024, sb = b % 1024, swz = sb ^ (((sb >> 9) & 1) << 5); R = (st >> 1) * 16 + swz / 64; C = (st & 1) * 32 + (swz % 64) / 2; }
__host__ __device__ __forceinline__ int perm32(int rho) { const int n = rho >> 4, i = rho & 15; return 8 * (i >> 2) + 4 * n + (i & 3); }

struct Unit { int pm, pn, z; };
struct Gemm { const bf16_t* A; const bf16_t* Bt; };
template <int LDA_, int LDB_, int K_, int NM_, int NN_, int Z_, int AZ_, int BZ_, int KSA_ = 128, long APANEL_ = 0> struct Dims { static constexpr int LDA = LDA_, LDB = LDB_, K = K_, NM = NM_, NN = NN_, Z = Z_, AZ = AZ_, BZ = BZ_, KSA = KSA_; static constexpr long APANEL = APANEL_ ? APANEL_ : (long)256 * LDA_ * 2; };

__device__ __forceinline__ void tile_of(int L, int nM, int nN, int& pm, int& pn) {
    const int nwg = nM * nN; int wgid = L;
    { const int q = nwg / NXCD, r = nwg % NXCD, xcd = wgid % NXCD, off = wgid / NXCD; wgid = (xcd < r ? xcd * (q + 1) : r * (q + 1) + (xcd - r) * q) + off; }
    const int nig = WGM * nN, gid = wgid / nig, fm = gid * WGM, gsz = (nM - fm) < WGM ? (nM - fm) : WGM;
    pm = fm + ((wgid % nig) % gsz); pn = (wgid % nig) / gsz;
}
template <class D> struct TileOrder {
    int G, c;
    __device__ __forceinline__ bool next(int i, Unit& u) const {
        const int j = i / D::Z; const int L = j * G + c; if (L >= D::NM * D::NN) return false;
        tile_of(L, D::NM, D::NN, u.pm, u.pn); u.z = i - j * D::Z; return true;
    }
    __device__ __forceinline__ size_t a_off(const Unit& u) const { return (size_t)u.pm * (size_t)D::APANEL + (size_t)u.z * D::AZ; }
    __device__ __forceinline__ size_t b_off(const Unit& u) const { return (size_t)u.pn * ((size_t)256 * D::LDB * 2) + (size_t)u.z * D::BZ; }
};

typedef int i32x4v __attribute__((ext_vector_type(4)));
template <class E, class = void> struct epi_i8 : std::false_type {};
template <class E> struct epi_i8<E, std::void_t<decltype(E::I8)>> : std::bool_constant<E::I8> {};
typedef int i32x8v __attribute__((ext_vector_type(8)));
__device__ __forceinline__ i32x8v cat8(const bf16x8& lo, const bf16x8& hi) { const i32x4v a = __builtin_bit_cast(i32x4v, lo), b = __builtin_bit_cast(i32x4v, hi); return __builtin_shufflevector(a, b, 0, 1, 2, 3, 4, 5, 6, 7); }
template <class D, class Epi, class Sched>
__device__ __forceinline__ void gemm_phase(LAS unsigned char* lds, const Gemm g, const Sched& S, const Epi& E, const int wid) {
    const int lane = lane_id_fresh(), tid = wid * 64 + lane, wr = wid >> 2, wc = wid & 3, fr = lane & 15, fq = lane >> 4;
    constexpr int nt = D::K / BK;
    unsigned voffA[2], voffB[2];
#pragma unroll
    for (int i = 0; i < 2; ++i) { int R, C; stage_rc(tid * 16 + i * 8192, R, C); const int Rb = Epi::PERM ? ((R & ~31) + perm32(R & 31)) : R;
        voffA[i] = (unsigned)(R * D::LDA + C) * 2u; voffB[i] = (unsigned)(Rb * D::LDB + C) * 2u; }
    constexpr size_t kstep = (size_t)(BK * 2), kstepA = (size_t)D::KSA;
    constexpr size_t hstepA = (size_t)HALF * D::LDA * 2, hstepB = (size_t)HALF * D::LDB * 2;
    const unsigned ldsw = (unsigned)wid * 1024u;
    const unsigned ldsb = __builtin_amdgcn_readfirstlane((unsigned)(size_t)lds + ldsw);
    const int aoff = lds_byte(wr * 64 + fr, fq * 8), boff = lds_byte(wc * 32 + fr, fq * 8);
#define PG8_SA(b, h) (((b) * 2 + (h)) * HTB)
#define PG8_SB(b, h) ((4 + (b) * 2 + (h)) * HTB)
#define PG8_STAGE(bufoff, gbase, voff) do { _Pragma("unroll") for (int _i = 0; _i < 2; ++_i) { \
        if constexpr (Epi::F8 || epi_i8<Epi>::value) asm volatile("s_mov_b32 m0, %0\n\ts_nop 0\n\tglobal_load_lds_dwordx4 %1, %2" :: "s"(ldsb + (unsigned)((bufoff) + _i * 8192)), "v"((voff)[_i]), "s"((const char*)(gbase)) : "memory", "m0");   \
        else __builtin_amdgcn_global_load_lds((const unsigned*)((const char*)(gbase) + (voff)[_i]), (LAS unsigned*)(lds + (bufoff) + ldsw + _i * 8192), 16, 0, 0); } } while (0)
#define PG8_LDA(dst, b, h) do { _Pragma("unroll") for (int m = 0; m < 4; ++m) _Pragma("unroll") for (int k = 0; k < 2; ++k) dst[m][k] = *(const LAS bf16x8*)(lds + PG8_SA(b, h) + aoff + m * 2048 + k * 1024); } while (0)
#define PG8_LDB(dst, b, h) do { _Pragma("unroll") for (int n = 0; n < 2; ++n) _Pragma("unroll") for (int k = 0; k < 2; ++k) dst[n][k] = *(const LAS bf16x8*)(lds + PG8_SB(b, h) + boff + n * 2048 + k * 1024); } while (0)
#define PG8_MMA(ai, bj, At, Bt) do { __builtin_amdgcn_s_setprio(1); \
        if constexpr (Epi::F8) { _Pragma("unroll") for (int m = 0; m < 4; ++m) _Pragma("unroll") for (int n = 0; n < 2; ++n) \
            acc[ai][bj][m][n] = __builtin_amdgcn_mfma_scale_f32_16x16x128_f8f6f4(cat8(Bt[n][0], Bt[n][1]), cat8(At[m][0], At[m][1]), acc[ai][bj][m][n], 0, 0, 0, 0, 0, 0); } \
        else if constexpr (epi_i8<Epi>::value) { _Pragma("unroll") for (int m = 0; m < 4; ++m) _Pragma("unroll") for (int n = 0; n < 2; ++n) _Pragma("unroll") for (int k = 0; k < 2; ++k) \
            acc[ai][bj][m][n] = __builtin_bit_cast(f32x4, __builtin_amdgcn_mfma_i32_16x16x64_i8(__builtin_bit_cast(i32x4v, Bt[n][k]), __builtin_bit_cast(i32x4v, At[m][k]), __builtin_bit_cast(i32x4v, acc[ai][bj][m][n]), 0, 0, 0)); } \
        else { _Pragma("unroll") for (int m = 0; m < 4; ++m) _Pragma("unroll") for (int n = 0; n < 2; ++n) _Pragma("unroll") for (int k = 0; k < 2; ++k) \
            acc[ai][bj][m][n] = __builtin_amdgcn_mfma_f32_16x16x32_bf16(Bt[n][k], At[m][k], acc[ai][bj][m][n], 0, 0, 0); } \
        __builtin_amdgcn_s_setprio(0); } while (0)
#define PG8_WAIT_V(n) asm volatile("s_waitcnt vmcnt(" #n ")" ::: "memory")
#define PG8_WAIT_L(n) asm volatile("s_waitcnt lgkmcnt(" #n ")" ::: "memory")
#define PG8_BAR __builtin_amdgcn_s_barrier()
#define PG8_SCHED __builtin_amdgcn_sched_barrier(0)
    Unit cur, nxt; int ui = 0;
    if (!S.next(0, cur)) return;
    f32x4 acc[2][2][4][2];
#pragma unroll
    for (int a = 0; a < 2; ++a)
#pragma unroll
        for (int b = 0; b < 2; ++b)
#pragma unroll
            for (int m = 0; m < 4; ++m)
#pragma unroll
                for (int n = 0; n < 2; ++n) acc[a][b][m][n] = (f32x4){0.f, 0.f, 0.f, 0.f};
    bf16x8 At[4][2], B0[2][2], B1[2][2];
    const char* cA = (const char*)g.A + S.a_off(cur); const char* cB = (const char*)g.Bt + S.b_off(cur);
    PG8_STAGE(PG8_SB(0, 0), cB, voffB); PG8_STAGE(PG8_SB(0, 1), cB + hstepB, voffB); PG8_STAGE(PG8_SA(0, 0), cA, voffA); PG8_STAGE(PG8_SA(0, 1), cA + hstepA, voffA);
    if (wr == 1) PG8_BAR;
    PG8_WAIT_V(2); PG8_BAR;
    PG8_STAGE(PG8_SB(1, 0), cB + kstep, voffB); PG8_STAGE(PG8_SA(1, 0), cA + kstepA, voffA); PG8_STAGE(PG8_SB(1, 1), cB + hstepB + kstep, voffB);
    PG8_WAIT_V(6); PG8_BAR;
    for (;;) {
        const bool has_next = S.next(ui + 1, nxt);
        const char* nA = has_next ? (const char*)g.A + S.a_off(nxt) : cA; const char* nB = has_next ? (const char*)g.Bt + S.b_off(nxt) : cB;
        for (int t = 0; t < nt; t += 2) {
            const bool last = (t == nt - 2);
            const char* a1 = cA + (size_t)(t + 1) * kstepA;
            const char* a2 = last ? nA : cA + (size_t)(t + 2) * kstepA; const char* b2 = last ? nB : cB + (size_t)(t + 2) * kstep;
            const char* a3 = a2 + kstepA; const char* b3 = b2 + kstep;
            PG8_LDB(B0, 0, 0); PG8_LDB(B1, 0, 1); PG8_SCHED; PG8_LDA(At, 0, 0); PG8_STAGE(PG8_SA(1, 1), a1 + hstepA, voffA);
            PG8_WAIT_V(8); PG8_WAIT_L(0); PG8_BAR; PG8_MMA(0, 0, At, B0); PG8_MMA(0, 1, At, B1); PG8_BAR; PG8_SCHED;
            PG8_LDA(At, 0, 1); PG8_STAGE(PG8_SB(0, 0), b2, voffB); PG8_STAGE(PG8_SB(0, 1), b2 + hstepB, voffB); PG8_STAGE(PG8_SA(0, 0), a2, voffA);
            PG8_WAIT_V(8); PG8_WAIT_L(0); PG8_BAR; PG8_MMA(1, 0, At, B0); PG8_MMA(1, 1, At, B1); PG8_BAR; PG8_SCHED;
            PG8_LDB(B0, 1, 0); PG8_LDB(B1, 1, 1); PG8_SCHED; PG8_LDA(At, 1, 0); PG8_STAGE(PG8_SA(0, 1), a2 + hstepA, voffA);
            PG8_WAIT_V(8); PG8_WAIT_L(0); PG8_BAR; PG8_MMA(0, 0, At, B0); PG8_MMA(0, 1, At, B1); PG8_BAR; PG8_SCHED;
            PG8_LDA(At, 1, 1); PG8_STAGE(PG8_SB(1, 0), b3, voffB); PG8_STAGE(PG8_SB(1, 1), b3 + hstepB, voffB); PG8_STAGE(PG8_SA(1, 0), a3, voffA);
            PG8_WAIT_V(8); PG8_WAIT_L(0); PG8_BAR; PG8_MMA(1, 0, At, B0); PG8_MMA(1, 1, At, B1); PG8_BAR; PG8_SCHED;
            if constexpr (Epi::HOOK) { if ((t & 7) == 6 && t != nt - 2) E.mid(acc, cur, t >> 3, wr, wc, fr, fq); }
        }
        if (wr == 0) PG8_BAR;
        if constexpr (!Epi::AFTER_DRAIN) E(acc, cur, wr, wc, fr, fq);
        if (!has_next) break;
#pragma unroll
        for (int a = 0; a < 2; ++a)
#pragma unroll
            for (int b = 0; b < 2; ++b)
#pragma unroll
                for (int m = 0; m < 4; ++m)
#pragma unroll
                    for (int n = 0; n < 2; ++n) acc[a][b][m][n] = (f32x4){0.f, 0.f, 0.f, 0.f};
        cur = nxt; cA = nA; cB = nB; ++ui;
        if (wr == 1) PG8_BAR;
    }
    PG8_WAIT_V(0);
    PG8_BAR;
    if constexpr (Epi::AFTER_DRAIN) E.fused(acc, cur, wr, wc, fr, fq, lds, tid);
#undef PG8_SA
#undef PG8_SB
#undef PG8_STAGE
#undef PG8_LDA
#undef PG8_LDB
#undef PG8_MMA
#undef PG8_WAIT_V
#undef PG8_WAIT_L
#undef PG8_BAR
#undef PG8_SCHED
}

template <bool F8_> struct EpiBf16T {
    static constexpr bool PERM = true, HOOK = false, AFTER_DRAIN = false, F8 = F8_;
    bf16_t* O; int ldc;
    __device__ __forceinline__ void operator()(const f32x4 (&acc)[2][2][4][2], const Unit& u, int wr, int wc, int fr, int fq) const {
        if constexpr (F8_) { const int t = lane_id_fresh(); fr = t & 15; fq = t >> 4; }
        const int row0 = u.pm * BM + wr * 64 + fr, col0 = u.pn * BM + wc * 32 + 8 * fq;
        constexpr float SC = F8_ ? (1.0f / 64.0f) : 1.0f;
#pragma unroll
        for (int ai = 0; ai < 2; ++ai)
#pragma unroll
            for (int m = 0; m < 4; ++m) { bf16_t* rowp = O + (size_t)(row0 + ai * HALF + m * 16) * ldc + col0;
#pragma unroll
                for (int bj = 0; bj < 2; ++bj) { const f32x4 v0 = acc[ai][bj][m][0] * SC, v1 = acc[ai][bj][m][1] * SC;
                    u32x4 w; w.x = cvt_pk_bf16(v0[0], v0[1]); w.y = cvt_pk_bf16(v0[2], v0[3]); w.z = cvt_pk_bf16(v1[0], v1[1]); w.w = cvt_pk_bf16(v1[2], v1[3]);
                    *(u32x4*)(rowp + bj * HALF) = w; } }
    }
};
typedef EpiBf16T<false> EpiBf16;
struct EpiSwiGLU {
    static constexpr bool PERM = true, HOOK = false, AFTER_DRAIN = false, F8 = false, I8 = true;
    bf16_t* O; int ldc; const float* sw; const float* hs;
    __device__ __forceinline__ void operator()(const f32x4 (&acc)[2][2][4][2], const Unit& u, int wr, int wc, int fr, int fq) const {
        const int col0 = u.pn * HALF + wc * 32 + 8 * fq;
        bf16_t* tile = O + (((size_t)u.pm * (ldc / 64) + (col0 >> 6)) * 256 + wr * 64 + fr) * 64 + (col0 & 63);
        const float sh = hs[u.pm >> 5];
        const float* swp = sw + u.pn * BM + wc * 32 + 8 * fq;
        f32x4 sg[2], su[2];
#pragma unroll
        for (int n = 0; n < 2; ++n) { sg[n] = *(const f32x4*)(swp + 4 * n) * sh; su[n] = *(const f32x4*)(swp + HALF + 4 * n) * sh; }
#pragma unroll
        for (int ai = 0; ai < 2; ++ai)
#pragma unroll
            for (int m = 0; m < 4; ++m) { bf16_t* rowp = tile + (size_t)(ai * HALF + m * 16) * 64;
                float o[8];
#pragma unroll
                for (int n = 0; n < 2; ++n)
#pragma unroll
                    for (int j = 0; j < 4; ++j) { const float ag = acc[ai][0][m][n][j], au = acc[ai][1][m][n][j];
                        const float gg = (float)__float_as_int(ag) * sg[n][j], uu = (float)__float_as_int(au) * su[n][j]; o[n * 4 + j] = gg * fsigmoid(gg) * uu; }
                u32x4 w; w.x = cvt_pk_bf16(o[0], o[1]); w.y = cvt_pk_bf16(o[2], o[3]); w.z = cvt_pk_bf16(o[4], o[5]); w.w = cvt_pk_bf16(o[6], o[7]);
                __builtin_nontemporal_store(w, (u32x4*)rowp); }
    }
};
struct EpiProj {
    static constexpr bool PERM = true, HOOK = false, AFTER_DRAIN = false, F8 = false, I8 = true;
    bf16_t* PJ; bf16_t* GT; bf16_t* KF; bf16_t* VF; float* kmean; unsigned* kn2;
    const float* hr; const float* sg;
    __device__ __forceinline__ void operator()(const f32x4 (&acci)[2][2][4][2], const Unit& u, int wr, int wc, int fr, int fq) const {
        const int pn = u.pn, row0 = u.pm * BM + wr * 64 + fr, cw = wc * 32 + 8 * fq;
        f32x4 acc[2][2][4][2];
        { f32x4 cs[2][2]; float rs8[2][4];
#pragma unroll
            for (int bj = 0; bj < 2; ++bj)
#pragma unroll
                for (int n = 0; n < 2; ++n) cs[bj][n] = *(const f32x4*)(sg + pn * BM + bj * HALF + cw + 4 * n);
#pragma unroll
            for (int ai = 0; ai < 2; ++ai)
#pragma unroll
                for (int m = 0; m < 4; ++m) rs8[ai][m] = hr[(size_t)row0 + ai * HALF + m * 16];
#pragma unroll
            for (int ai = 0; ai < 2; ++ai)
#pragma unroll
                for (int bj = 0; bj < 2; ++bj)
#pragma unroll
                    for (int m = 0; m < 4; ++m)
#pragma unroll
                        for (int n = 0; n < 2; ++n)
#pragma unroll
                            for (int j = 0; j < 4; ++j) { const float a = acci[ai][bj][m][n][j]; acc[ai][bj][m][n][j] = (float)__float_as_int(a) * (rs8[ai][m] * cs[bj][n][j]); } }
        if (pn >= 12 && pn < 16) {
            bf16_t* base = PJ + PJ_GLU + (pn - 12) * HALF + cw;
#pragma unroll
            for (int ai = 0; ai < 2; ++ai)
#pragma unroll
                for (int m = 0; m < 4; ++m) { bf16_t* rowp = base + (size_t)(row0 + ai * HALF + m * 16) * LDP;
                    float o[8];
#pragma unroll
                    for (int n = 0; n < 2; ++n)
#pragma unroll
                        for (int j = 0; j < 4; ++j) o[n * 4 + j] = acc[ai][0][m][n][j] * fsigmoid(acc[ai][1][m][n][j]);
                    u32x4 w; w.x = cvt_pk_bf16(o[0], o[1]); w.y = cvt_pk_bf16(o[2], o[3]); w.z = cvt_pk_bf16(o[4], o[5]); w.w = cvt_pk_bf16(o[6], o[7]);
                    *(u32x4*)rowp = w; }
        } else {
            const int col = pn < 12 ? pn * BM : PJ_DQ + (pn - 16) * BM;
            const float sc = (pn < 2 || pn == 6 || pn == 7) ? C2_128 : ((pn == 16 || pn == 17) ? C2_64 : 1.0f);
            if (pn == 2 || pn == 3) {
                const int bb = u.pm >> 5, g32 = 8 * (u.pm & 31) + 2 * wr;
#pragma unroll
                for (int ai = 0; ai < 2; ++ai)
#pragma unroll
                    for (int m = 0; m < 4; ++m)
#pragma unroll
                        for (int bj = 0; bj < 2; ++bj) { const f32x4 v0 = acc[ai][bj][m][0], v1 = acc[ai][bj][m][1];
                            const int hh = (pn - 2) * 2 + bj;
                            bf16_t* dst = KF + ((((size_t)((bb * 4 + hh) * 256 + g32 + 4 * ai + (m >> 1)) * 8 + 2 * wc + (fq >> 1)) * 2 + (fq & 1)) * 32 + 16 * (m & 1) + fr) * 8;
                            u32x4 w; w.x = cvt_pk_bf16(v0[0], v0[1]); w.y = cvt_pk_bf16(v0[2], v0[3]); w.z = cvt_pk_bf16(v1[0], v1[1]); w.w = cvt_pk_bf16(v1[2], v1[3]);
                            *(u32x4*)dst = w; }
            } else if (pn == 4 || pn == 5) {
                const int bb = u.pm >> 5, g16 = 16 * (u.pm & 31) + 4 * wr;
#pragma unroll
                for (int ai = 0; ai < 2; ++ai)
#pragma unroll
                    for (int m = 0; m < 4; ++m)
#pragma unroll
                        for (int bj = 0; bj < 2; ++bj) { const int hh = (pn - 4) * 2 + bj;
                            bf16_t* dst = VF + ((((size_t)((bb * 4 + hh) * 512 + g16 + 8 * ai + m) * 4 + wc) * 2 + (fr >> 3)) * 32 + 8 * fq) * 8 + (fr & 7);
#pragma unroll
                            for (int n = 0; n < 2; ++n)
#pragma unroll
                                for (int j = 0; j < 4; ++j) { const float v = acc[ai][bj][m][n][j]; dst[(4 * n + j) * 8] = (bf16_t)(cvt_pk_bf16(v, v) & 0xffffu); } }
            } else {
            bf16_t* base = PJ + col + cw;
#pragma unroll
            for (int ai = 0; ai < 2; ++ai)
#pragma unroll
                for (int m = 0; m < 4; ++m) { bf16_t* rowp = base + (size_t)(row0 + ai * HALF + m * 16) * LDP;
#pragma unroll
                    for (int bj = 0; bj < 2; ++bj) { const f32x4 v0 = acc[ai][bj][m][0] * sc, v1 = acc[ai][bj][m][1] * sc;
                        u32x4 w; w.x = cvt_pk_bf16(v0[0], v0[1]); w.y = cvt_pk_bf16(v0[2], v0[3]); w.z = cvt_pk_bf16(v1[0], v1[1]); w.w = cvt_pk_bf16(v1[2], v1[3]);
                        *(u32x4*)(rowp + bj * HALF) = w; } }
            }
            if (pn == 8 || pn == 9) {
#pragma unroll
                for (int bj = 0; bj < 2; ++bj) { float mx = 0.f;
#pragma unroll
                    for (int ai = 0; ai < 2; ++ai)
#pragma unroll
                        for (int m = 0; m < 4; ++m) { const f32x4 a0 = acc[ai][bj][m][0], a1 = acc[ai][bj][m][1];
                            float q = (a0[0] * a0[0] + a0[1] * a0[1]) + (a0[2] * a0[2] + a0[3] * a0[3]) + (a1[0] * a1[0] + a1[1] * a1[1]) + (a1[2] * a1[2] + a1[3] * a1[3]);
                            q += shx<16>(q); q += shx<32>(q); mx = fmaxf(mx, q); }
                    mx = fmaxf(mx, shx<1>(mx)); mx = fmaxf(mx, shx<2>(mx)); mx = fmaxf(mx, shx<4>(mx)); mx = fmaxf(mx, shx<8>(mx));
                    if (fr == 0 && fq == 0) atomicMax(kn2 + ((u.pm >> 5) * 4 + (pn - 8) * 2 + bj) * 64, __float_as_uint(mx)); }
            }
            if (pn == 2 || pn == 3) {
                float* kp = kmean + (size_t)u.pm * 512 + (pn - 2) * BM + cw;
#pragma unroll
                for (int bj = 0; bj < 2; ++bj)
#pragma unroll
                    for (int n = 0; n < 2; ++n)
#pragma unroll
                        for (int j = 0; j < 4; ++j) { float s = 0.f;
#pragma unroll
                            for (int ai = 0; ai < 2; ++ai)
#pragma unroll
                                for (int m = 0; m < 4; ++m) s += acc[ai][bj][m][n][j];
                            s += shx<1>(s); s += shx<2>(s); s += shx<4>(s); s += shx<8>(s);
                            if (fr == 0) unsafeAtomicAdd(kp + bj * HALF + n * 4 + j, s); }
            }
        }
    }
};
struct EpiGate8 {
    static constexpr bool PERM = true, HOOK = false, AFTER_DRAIN = false, F8 = false, I8 = true;
    bf16_t* GT; const float* hr; const float* sg;
    __device__ __forceinline__ void operator()(const f32x4 (&acc)[2][2][4][2], const Unit& u, int wr, int wc, int fr, int fq) const {
        f32x4 cs[2][2];
#pragma unroll
        for (int bj = 0; bj < 2; ++bj)
#pragma unroll
            for (int n = 0; n < 2; ++n) cs[bj][n] = *(const f32x4*)(sg + u.pn * BM + bj * HALF + wc * 32 + 8 * fq + 4 * n) * (-LOG2E);
        float rs8[2][4];
#pragma unroll
        for (int ai = 0; ai < 2; ++ai)
#pragma unroll
            for (int m = 0; m < 4; ++m) rs8[ai][m] = hr[(size_t)u.pm * BM + ai * HALF + wr * 64 + m * 16 + fr];
        asm volatile("" ::: "memory");
        unsigned char* base = (unsigned char*)GT + ((size_t)u.pm * 32 + u.pn) * 65536 + (size_t)((unsigned)((wr * 4 + wc) * 64 + lane_id_fresh()) * 16u);
#pragma unroll
        for (int ai = 0; ai < 2; ++ai)
#pragma unroll
            for (int m = 0; m < 4; ++m) { u32x4 w; const float rs = rs8[ai][m];
#pragma unroll
                for (int bj = 0; bj < 2; ++bj) { const f32x4 v0 = acc[ai][bj][m][0], v1 = acc[ai][bj][m][1];
                    unsigned q[8];
#pragma unroll
                    for (int k = 0; k < 4; ++k) { const float a0 = v0[k], a1 = v1[k];
                        q[k] = (unsigned)fmaxf(__builtin_amdgcn_rcpf(1.0f + __builtin_amdgcn_exp2f((float)__float_as_int(a0) * (rs * cs[bj][0][k]))) * 255.0f + 0.5f, 1.0f);
                        q[4 + k] = (unsigned)fmaxf(__builtin_amdgcn_rcpf(1.0f + __builtin_amdgcn_exp2f((float)__float_as_int(a1) * (rs * cs[bj][1][k]))) * 255.0f + 0.5f, 1.0f); }
                    const unsigned lo = q[0] | (q[1] << 8) | (q[2] << 16) | (q[3] << 24), hi = q[4] | (q[5] << 8) | (q[6] << 16) | (q[7] << 24);
                    if (bj == 0) { w.x = lo; w.y = hi; } else { w.z = lo; w.w = hi; } }
                __builtin_nontemporal_store(w, (u32x4*)(base + (ai * 4 + m) * 8192)); }
    }
};
struct EpiMerge {
    static constexpr bool PERM = true, HOOK = true, AFTER_DRAIN = false, F8 = false;
    const unsigned char* GT; bf16_t* Y;
    __device__ __forceinline__ void mid(f32x4 (&acc)[2][2][4][2], const Unit& u, int z, int wr, int wc, int fr, int fq) const {
        const unsigned lin = (unsigned)opaque_v(((wr * 4 + wc) * 64 + fq * 16 + fr));
        const unsigned char* t0 = GT + ((size_t)u.pm * 32 + z * 8 + u.pn) * 65536;
#pragma unroll
        for (int ai = 0; ai < 2; ++ai) {
            u32x4 ga[4], gb[4];
#pragma unroll
            for (int m = 0; m < 4; ++m) { ga[m] = *(const u32x4*)(t0 + lin * 16u + (ai * 4 + m) * 8192); gb[m] = *(const u32x4*)(t0 + 8 * 65536 + lin * 16u + (ai * 4 + m) * 8192); }
            asm volatile("" ::: "memory");
#pragma unroll
            for (int m = 0; m < 4; ++m)
#pragma unroll
                for (int bj = 0; bj < 2; ++bj) { const u32x2 a = bj ? (u32x2){ga[m].z, ga[m].w} : (u32x2){ga[m].x, ga[m].y}, b = bj ? (u32x2){gb[m].z, gb[m].w} : (u32x2){gb[m].x, gb[m].y};
#pragma unroll
                    for (int k = 0; k < 4; ++k) { const float na = (float)((a.x >> (8 * k)) & 255u), nb = (float)((b.x >> (8 * k)) & 255u), nc = (float)((a.y >> (8 * k)) & 255u), nd = (float)((b.y >> (8 * k)) & 255u);
                        acc[ai][bj][m][0][k] *= na * __builtin_amdgcn_rcpf(nb); acc[ai][bj][m][1][k] *= nc * __builtin_amdgcn_rcpf(nd); } }
            asm volatile("" ::: "memory");
        }
    }
    __device__ __forceinline__ void operator()(const f32x4 (&acc)[2][2][4][2], const Unit& u, int wr, int wc, int fr, int fq) const {
        const int row0 = u.pm * BM + wr * 64 + fr, col0 = u.pn * BM + wc * 32 + 8 * fq;
        const unsigned lin = (unsigned)opaque_v(((wr * 4 + wc) * 64 + fq * 16 + fr));
        const unsigned char* t3 = GT + ((size_t)u.pm * 32 + 3 * 8 + u.pn) * 65536;
#pragma unroll
        for (int ai = 0; ai < 2; ++ai) {
            u32x4 gw[4];
#pragma unroll
            for (int m = 0; m < 4; ++m) gw[m] = *(const u32x4*)(t3 + lin * 16u + (ai * 4 + m) * 8192);
            asm volatile("" ::: "memory");
#pragma unroll
            for (int m = 0; m < 4; ++m)
#pragma unroll
                for (int bj = 0; bj < 2; ++bj) { const u32x2 g = bj ? (u32x2){gw[m].z, gw[m].w} : (u32x2){gw[m].x, gw[m].y};
                    const f32x4 v0 = acc[ai][bj][m][0] * (1.0f / 255.0f), v1 = acc[ai][bj][m][1] * (1.0f / 255.0f);
                    u32x4 w;
                    w.x = cvt_pk_bf16((float)(g.x & 255u) * v0[0], (float)((g.x >> 8) & 255u) * v0[1]);
                    w.y = cvt_pk_bf16((float)((g.x >> 16) & 255u) * v0[2], (float)(g.x >> 24) * v0[3]);
                    w.z = cvt_pk_bf16((float)(g.y & 255u) * v1[0], (float)((g.y >> 8) & 255u) * v1[1]);
                    w.w = cvt_pk_bf16((float)((g.y >> 16) & 255u) * v1[2], (float)(g.y >> 24) * v1[3]);
                    *(u32x4*)(Y + (size_t)(row0 + ai * HALF + m * 16) * DM + col0 + bj * HALF) = w; }
            asm volatile("" ::: "memory");
        }
    }
};

template <class D> struct SliceOrder {
    int slice, c;
    __device__ __forceinline__ bool next(int i, Unit& u) const { if (i > 0) return false; u.pm = slice * 32 + (c & 7) * 4 + ((c >> 3) & 3); u.pn = c >> 5; u.z = 0; return true; }
    __device__ __forceinline__ size_t a_off(const Unit& u) const { return (size_t)u.pm * (size_t)D::APANEL; }
    __device__ __forceinline__ size_t b_off(const Unit& u) const { return (size_t)u.pn * ((size_t)256 * D::LDB * 2); }
};
struct RowX {
    float* slots; gu32* cnt; gu32* tmo;
    static constexpr int XOFF = RING_BYTES + 4096;
    __device__ __forceinline__ void publish(const float (&part)[2][4], const Unit& u, int wr, int wc, int fr, int fq, LAS unsigned char* lds, int tid) const {
        LAS float* P = (LAS float*)(lds + XOFF);
#pragma unroll
        for (int ai = 0; ai < 2; ++ai)
#pragma unroll
            for (int m = 0; m < 4; ++m) { float v = part[ai][m]; v += shx<16>(v); v += shx<32>(v); if (fq == 0) P[(ai * HALF + wr * 64 + m * 16 + fr) * 4 + wc] = v; }
        asm volatile("s_waitcnt lgkmcnt(0)" ::: "memory"); __builtin_amdgcn_s_barrier(); asm volatile("" ::: "memory");
        if (tid < 256) { const float t = (P[tid * 4 + 0] + P[tid * 4 + 1]) + (P[tid * 4 + 2] + P[tid * 4 + 3]);
            __hip_atomic_store((unsigned*)slots + ((size_t)u.pm * 256 + tid) * 8 + u.pn, __float_as_uint(t), __ATOMIC_RELAXED, __HIP_MEMORY_SCOPE_AGENT); }
        asm volatile("s_waitcnt vmcnt(0)" ::: "memory"); __builtin_amdgcn_s_barrier(); asm volatile("" ::: "memory");
        if (tid == 0) __hip_atomic_fetch_add(cnt + 16 * u.pm, 1u, __ATOMIC_RELAXED, __HIP_MEMORY_SCOPE_AGENT);
    }
    __device__ __forceinline__ void collect(const Unit& u, LAS unsigned char* lds, int tid) const {
        LAS float* S = (LAS float*)(lds + XOFF + 4096);
        if (tid == 0) { unsigned sp = 0; while (__hip_atomic_load(cnt + 16 * u.pm, __ATOMIC_RELAXED, __HIP_MEMORY_SCOPE_AGENT) < 8u) { __builtin_amdgcn_s_sleep(1); if (++sp > (1u << 20)) { __hip_atomic_store(tmo, 1u, __ATOMIC_RELAXED, __HIP_MEMORY_SCOPE_AGENT); break; } }
            __builtin_amdgcn_fence(__ATOMIC_ACQUIRE, "agent"); asm volatile("s_waitcnt vmcnt(0)" ::: "memory"); }
        __builtin_amdgcn_s_barrier(); asm volatile("" ::: "memory");
        if (tid < 256) { const f32x4 a = *(const f32x4*)(slots + ((size_t)u.pm * 256 + tid) * 8), b = *(const f32x4*)(slots + ((size_t)u.pm * 256 + tid) * 8 + 4);
            const float t = ((a.x + a.y) + (a.z + a.w)) + ((b.x + b.y) + (b.z + b.w)); S[tid] = 1.0f / sqrtf(t * (1.0f / 2048.0f) + 1e-6f); }
        asm volatile("s_waitcnt vmcnt(0) lgkmcnt(0)" ::: "memory"); __builtin_amdgcn_s_barrier(); asm volatile("" ::: "memory");
    }
};
struct EpiResNorm {
    static constexpr bool PERM = true, HOOK = false, AFTER_DRAIN = true, F8 = false;
    const float* xf32; const bf16_t* xb; int xb_pitch, xb_off;
    bf16_t* xo; int xo_pitch, xo_off; float* outf;
    const float* res_gate; const float* res_gain;
    bf16_t* hout; const float* nx_gain; const float* nx_scale; const float* nx_shift; const float* hs;
    RowX ex1, ex2;
    __device__ __forceinline__ void stage_x(int ai, const Unit& u, int wid, int lane, LAS unsigned char* lds) const {
        const size_t grow0 = (size_t)u.pm * BM + ai * HALF;
        if (xf32) {
#pragma unroll
            for (int j = 0; j < 16; ++j) { const int r = j * 8 + wid; const int ch = lane ^ (r & 15);
                __builtin_amdgcn_global_load_lds((const unsigned*)(xf32 + (grow0 + r) * DM + u.pn * BM + ch * 4), (LAS unsigned*)(lds + r * 1024), 16, 0, 0); }
        } else {
#pragma unroll
            for (int j = 0; j < 8; ++j) { const int r = 2 * (j * 8 + wid) + (lane >> 5); const int ch = (lane & 31) ^ (r & 15);
                __builtin_amdgcn_global_load_lds((const unsigned*)(xb + (grow0 + r) * xb_pitch + xb_off + u.pn * BM + ch * 8), (LAS unsigned*)(lds + ai * 65536 + (j * 8 + wid) * 1024), 16, 0, 0); }
        }
    }
    __device__ __forceinline__ void residual_half(int ai, f32x4 (&acc)[2][2][4][2], float (&part)[2][4], const f32x4 (&g1)[2][2], const Unit& u, int wr, int wc, int fr, int fq, LAS unsigned char* lds) const {
        const LAS float* S = (const LAS float*)(lds + RowX::XOFF + 4096);
        const int col0 = u.pn * BM + wc * 32 + 8 * fq;
#pragma unroll
        for (int m = 0; m < 4; ++m) { const int rh = wr * 64 + m * 16 + fr, rl = ai * HALF + rh; const float r = S[rl]; const size_t grow = (size_t)u.pm * BM + rl; float q = 0.f;
#pragma unroll
            for (int bj = 0; bj < 2; ++bj) { const int c = col0 + bj * HALF;
                f32x4 x0, x1;
                if (xf32) { const int q0 = bj * 32 + wc * 8 + fq * 2; const LAS unsigned char* p = lds + rh * 1024; x0 = *(const LAS f32x4*)(p + ((q0 ^ fr) << 4)); x1 = *(const LAS f32x4*)(p + (((q0 + 1) ^ fr) << 4)); }
                else { const u32x4 w = *(const LAS u32x4*)(lds + ai * 65536 + rh * 512 + (((bj * 16 + wc * 4 + fq) ^ fr) << 4)); x0 = (f32x4){bf_lo(w.x), bf_hi(w.x), bf_lo(w.y), bf_hi(w.y)}; x1 = (f32x4){bf_lo(w.z), bf_hi(w.z), bf_lo(w.w), bf_hi(w.w)}; }
                f32x4 v0 = x0 + g1[bj][0] * (acc[ai][bj][m][0] * r), v1 = x1 + g1[bj][1] * (acc[ai][bj][m][1] * r);
                if (xo) { u32x4 w; w.x = cvt_pk_bf16(v0.x, v0.y); w.y = cvt_pk_bf16(v0.z, v0.w); w.z = cvt_pk_bf16(v1.x, v1.y); w.w = cvt_pk_bf16(v1.z, v1.w);
                    *(u32x4*)(xo + grow * xo_pitch + xo_off + c) = w;
                    v0 = (f32x4){bf_lo(w.x), bf_hi(w.x), bf_lo(w.y), bf_hi(w.y)}; v1 = (f32x4){bf_lo(w.z), bf_hi(w.z), bf_lo(w.w), bf_hi(w.w)}; }
                else { *(f32x4*)(outf + grow * DM + c) = v0; *(f32x4*)(outf + grow * DM + c + 4) = v1; }
                acc[ai][bj][m][0] = v0; acc[ai][bj][m][1] = v1;
                q += (v0.x * v0.x + v0.y * v0.y) + (v0.z * v0.z + v0.w * v0.w) + (v1.x * v1.x + v1.y * v1.y) + (v1.z * v1.z + v1.w * v1.w); }
            part[ai][m] = q;
            if (m & 1) asm volatile("" ::: "memory"); }
    }
    __device__ __forceinline__ void fused(f32x4 (&acc)[2][2][4][2], const Unit& u, int wr, int wc, int fr, int fq, LAS unsigned char* lds, int tid) const {
        const LAS float* S = (const LAS float*)(lds + RowX::XOFF + 4096);
        const int bt = u.pm >> 5, col0 = u.pn * BM + wc * 32 + 8 * fq, wid = wr * 4 + wc, lane = fq * 16 + fr;
        float part[2][4];
#pragma unroll
        for (int ai = 0; ai < 2; ++ai)
#pragma unroll
            for (int m = 0; m < 4; ++m) { float q = 0.f;
#pragma unroll
                for (int bj = 0; bj < 2; ++bj)
#pragma unroll
                    for (int n = 0; n < 2; ++n) { const f32x4 v = acc[ai][bj][m][n]; q += (v.x * v.x + v.y * v.y) + (v.z * v.z + v.w * v.w); }
                part[ai][m] = q; }
        ex1.publish(part, u, wr, wc, fr, fq, lds, tid);
        stage_x(0, u, wid, lane, lds); if (!xf32) stage_x(1, u, wid, lane, lds);
        f32x4 g1[2][2];
#pragma unroll
        for (int bj = 0; bj < 2; ++bj)
#pragma unroll
            for (int n = 0; n < 2; ++n) { const int c = col0 + bj * HALF + 4 * n; g1[bj][n] = *(const f32x4*)(res_gate + (size_t)bt * 12288 + c) * *(const f32x4*)(res_gain + c); }
        ex1.collect(u, lds, tid);
        residual_half(0, acc, part, g1, u, wr, wc, fr, fq, lds);
        if (xf32) { asm volatile("s_waitcnt lgkmcnt(0)" ::: "memory"); __builtin_amdgcn_s_barrier(); stage_x(1, u, wid, lane, lds); asm volatile("s_waitcnt vmcnt(0)" ::: "memory"); __builtin_amdgcn_s_barrier(); asm volatile("" ::: "memory"); }
        residual_half(1, acc, part, g1, u, wr, wc, fr, fq, lds);
        if (hout) {
            ex2.publish(part, u, wr, wc, fr, fq, lds, tid);
            f32x4 na[2][2], nb[2][2];
#pragma unroll
            for (int bj = 0; bj < 2; ++bj)
#pragma unroll
                for (int n = 0; n < 2; ++n) { const int c = col0 + bj * HALF + 4 * n; na[bj][n] = *(const f32x4*)(nx_gain + c) * (*(const f32x4*)(nx_scale + (size_t)bt * 12288 + c) + 1.0f); nb[bj][n] = *(const f32x4*)(nx_shift + (size_t)bt * 12288 + c); }
            ex2.collect(u, lds, tid);
            const float qinv = 1.0f / hs[bt];
#pragma unroll
            for (int ai = 0; ai < 2; ++ai)
#pragma unroll
                for (int m = 0; m < 4; ++m) { const int rl = ai * HALF + wr * 64 + m * 16 + fr; const float r = S[rl]; const size_t grow = (size_t)u.pm * BM + rl;
#pragma unroll
                    for (int bj = 0; bj < 2; ++bj) { const f32x4 h0 = ((acc[ai][bj][m][0] * r) * na[bj][0] + nb[bj][0]) * qinv, h1 = ((acc[ai][bj][m][1] * r) * na[bj][1] + nb[bj][1]) * qinv;
                        u32x2 w; w.x = pk4_i8(h0.x, h0.y, h0.z, h0.w); w.y = pk4_i8(h1.x, h1.y, h1.z, h1.w);
                        *(u32x2*)((unsigned char*)hout + grow * DM + col0 + bj * HALF) = w; } }
        }
    }
};
}

#define XB_TMO      128
#define XB_XCNT(j)  (256  + 64 * (j))
#define XB_XSUB(j)  (1280 + 64 * (j))
#define XB_XGEN(j)  (2304 + 64 * (j))
#define XB_TOP      3328
#define XB_TOPGEN   3392
#define XCD_BAR_WORDS 3456
#define XB_SPIN_CAP (1u << 18)
__device__ __forceinline__ unsigned xb_ld(unsigned* p)              { return __hip_atomic_load(p, __ATOMIC_RELAXED, __HIP_MEMORY_SCOPE_AGENT); }
__device__ __forceinline__ unsigned xb_add(unsigned* p, unsigned v) { return __hip_atomic_fetch_add(p, v, __ATOMIC_RELAXED, __HIP_MEMORY_SCOPE_AGENT); }
__device__ __forceinline__ unsigned xb_xcc_id() { return (unsigned)__builtin_amdgcn_s_getreg((3 << 11) | 20) & 0xFu; }
#define XB_SPIN(cond, bar) do { unsigned _sp = 0; while (cond) { __builtin_amdgcn_s_sleep(1); \
    if ((++_sp & 255u) == 0u) { if (xb_ld(&(bar)[XB_TMO])) break; if (_sp > XB_SPIN_CAP) { atomicAdd(&(bar)[XB_TMO], 1u); break; } } } } while (0)
struct XcdBarrier { unsigned* bar; unsigned x; volatile LAS unsigned* st; int wave; };
__device__ __forceinline__ XcdBarrier xcd_barrier_post(unsigned* bar, volatile LAS unsigned* st, int wave) {
    XcdBarrier b; b.bar = bar; b.x = xb_xcc_id(); b.st = st; b.wave = wave;
    if (wave == 0 && lane_id_fresh() == 0) (void)xb_add(&bar[XB_XCNT(b.x)], 1u);
    return b;
}
__device__ __forceinline__ void xcd_barrier_complete(unsigned* bar, unsigned x, unsigned& nloc, unsigned& nx) {
    const unsigned G = gridDim.x * gridDim.y * gridDim.z;
    unsigned sum, cnt, mine, sp = 0u;
    for (;;) {
        sum = 0u; cnt = 0u; mine = 0u;
#pragma unroll
        for (unsigned j = 0; j < 16; ++j) { const unsigned c = xb_ld(&bar[XB_XCNT(j)]); sum += c; cnt += (c > 0u) ? 1u : 0u; mine = (j == x) ? c : mine; }
        if (sum == G) break;
        __builtin_amdgcn_s_sleep(1);
        if ((++sp & 255u) == 0u) { if (xb_ld(&bar[XB_TMO])) break; if (sp > XB_SPIN_CAP) { atomicAdd(&bar[XB_TMO], 1u); break; } }
    }
    nloc = mine > 0u ? mine : 1u; nx = cnt > 0u ? cnt : 1u;
}
__device__ __forceinline__ void xcd_barrier(const XcdBarrier& b) {
    asm volatile("s_waitcnt vmcnt(0)" ::: "memory");
    __syncthreads();
    if (b.wave == 0 && lane_id_fresh() == 0) {
        unsigned* bar = b.bar; asm volatile("" : "+s"(bar));
        __builtin_amdgcn_s_waitcnt(0);
        unsigned nloc = b.st[0], nx = b.st[1];
        if (nloc == 0u) { xcd_barrier_complete(bar, b.x, nloc, nx); b.st[0] = nloc; b.st[1] = nx; }
        const unsigned old = xb_add(&bar[XB_XSUB(b.x)], 1u);
        const unsigned gen = old / nloc;
        if (old + 1u == (gen + 1u) * nloc) {
            __builtin_amdgcn_fence(__ATOMIC_RELEASE, "agent");
            asm volatile("s_waitcnt vmcnt(0)" ::: "memory");
            const unsigned og = xb_add(&bar[XB_TOP], 1u);
            const unsigned tg = og / nx;
            if (og + 1u == (tg + 1u) * nx) xb_add(&bar[XB_TOPGEN], 1u);
            else XB_SPIN(xb_ld(&bar[XB_TOPGEN]) == tg, bar);
            __builtin_amdgcn_fence(__ATOMIC_ACQUIRE, "agent");
            xb_add(&bar[XB_XGEN(b.x)], 1u);
            asm volatile("s_waitcnt vmcnt(0)" ::: "memory");
        } else {
            XB_SPIN(xb_ld(&bar[XB_XGEN(b.x)]) == gen, bar);
            __builtin_amdgcn_fence(__ATOMIC_ACQUIRE, "agent");
            asm volatile("s_waitcnt vmcnt(0)" ::: "memory");
        }
    }
    __syncthreads();
}

struct Args {
    const float *x, *c, *rel_bias, *w_mod, *b_mod, *mix_pre, *mix_post, *w_in, *fox_bias, *conv_w, *conv_b, *conv_g, *conv_beta, *sinks,
                *w_br_a, *w_br_b, *w_br_c, *w_br_d, *w_out, *ffn_pre, *ffn_post, *w_gate, *w_up, *w_down;
    float* out; unsigned char* ws; int ph_lo, ph_hi;
};
struct Frame {
    LAS unsigned char* lds; volatile LAS unsigned* MISC; gu32* ctl;
    int wave, G;
    __device__ __forceinline__ int lane_() const { return lane_id_fresh(); }
    __device__ __forceinline__ int tid_() const { return wave * 64 + lane_id_fresh(); }
    unsigned char* ws;
};

__device__ __forceinline__ int t5_bucket(int d) {
    if (d < 16) return d;
    int b = 15;
    b += (d >= 16); b += (d >= 21); b += (d >= 27); b += (d >= 35); b += (d >= 46); b += (d >= 59); b += (d >= 77); b += (d >= 99);
    b += (d >= 128); b += (d >= 166); b += (d >= 216); b += (d >= 280); b += (d >= 363); b += (d >= 470); b += (d >= 609); b += (d >= 790);
    return b;
}

__device__ __forceinline__ void transpose_item(const float* W, int ldw, int n0s, bf16* WT, int K, int drow0, int k0, LAS float* scr, int lane) {
#pragma unroll 8
    for (int i = 0; i < 32; ++i) { const int kk = 2 * i + (lane >> 5); scr[kk * 33 + (lane & 31)] = W[(size_t)(k0 + kk) * ldw + n0s + (lane & 31)]; }
    LDS_WAIT(); asm volatile("" ::: "memory");
    const int c = lane & 7;
#pragma unroll
    for (int j = 0; j < 4; ++j) { const int n = (lane >> 3) + 8 * j; const LAS float* s = scr + (8 * c) * 33 + n;
        u32x4 o; o.x = pk2(s[0 * 33], s[1 * 33]); o.y = pk2(s[2 * 33], s[3 * 33]); o.z = pk2(s[4 * 33], s[5 * 33]); o.w = pk2(s[6 * 33], s[7 * 33]);
        *(GAS u32x4*)(WT + (size_t)(drow0 + n) * K + k0 + 8 * c) = o; }
    LDS_WAIT(); asm volatile("" ::: "memory");
}
__device__ __forceinline__ void transpose_item8(const float* W, int ldw, int n0s, unsigned char* W8, int K, int drow0, int k0, LAS float* scr, int lane) {
#pragma unroll 8
    for (int i = 0; i < 32; ++i) { const int kk = 2 * i + (lane >> 5); scr[kk * 33 + (lane & 31)] = W[(size_t)(k0 + kk) * ldw + n0s + (lane & 31)] * 64.0f; }
    LDS_WAIT(); asm volatile("" ::: "memory");
    const int c = lane & 3;
#pragma unroll
    for (int j = 0; j < 2; ++j) { const int n = (lane >> 2) + 16 * j; const LAS float* s = scr + (16 * c) * 33 + n;
        u32x4 o; o.x = pk4_fp8(s[0 * 33], s[1 * 33], s[2 * 33], s[3 * 33]); o.y = pk4_fp8(s[4 * 33], s[5 * 33], s[6 * 33], s[7 * 33]);
        o.z = pk4_fp8(s[8 * 33], s[9 * 33], s[10 * 33], s[11 * 33]); o.w = pk4_fp8(s[12 * 33], s[13 * 33], s[14 * 33], s[15 * 33]);
        *(GAS u32x4*)(W8 + (size_t)(drow0 + n) * K + k0 + 16 * c) = o; }
    LDS_WAIT(); asm volatile("" ::: "memory");
}
__device__ __forceinline__ void transpose_item_i8(const float* W, int ldw, int n0s, unsigned char* W8, int K, int drow0, int k0, LAS float* scr, int lane, const LAS float* inv) {
#pragma unroll
    for (int i = 0; i < 8; ++i) { const int kk = 8 * i + (lane >> 3); const f32x4 v = *(const f32x4*)(W + (size_t)(k0 + kk) * ldw + n0s + 4 * (lane & 7));
        LAS float* d = scr + kk * 33 + 4 * (lane & 7); d[0] = v.x; d[1] = v.y; d[2] = v.z; d[3] = v.w; }
    LDS_WAIT(); asm volatile("" ::: "memory");
    const int c = lane & 3;
#pragma unroll
    for (int j = 0; j < 2; ++j) { const int n = (lane >> 2) + 16 * j; const LAS float* s = scr + (16 * c) * 33 + n; const float f = inv[n];
        u32x4 o; o.x = pk4_i8(s[0 * 33] * f, s[1 * 33] * f, s[2 * 33] * f, s[3 * 33] * f); o.y = pk4_i8(s[4 * 33] * f, s[5 * 33] * f, s[6 * 33] * f, s[7 * 33] * f);
        o.z = pk4_i8(s[8 * 33] * f, s[9 * 33] * f, s[10 * 33] * f, s[11 * 33] * f); o.w = pk4_i8(s[12 * 33] * f, s[13 * 33] * f, s[14 * 33] * f, s[15 * 33] * f);
        *(GAS u32x4*)(W8 + (size_t)(drow0 + n) * K + k0 + 16 * c) = o; }
    LDS_WAIT(); asm volatile("" ::: "memory");
}
__device__ __forceinline__ int map_in_row(int c) {
    if (c >= 3072 && c < 4096) { const int u = c - 3072; return u < 512 ? 3072 + 256 * (u >> 7) + (u & 127) : 3072 + 256 * ((u - 512) >> 7) + 128 + (u & 127); }
    return c;
}
__device__ __forceinline__ void p0_prologue(Frame& F, const Args& a) {
    {
        LAS float* ca = (LAS float*)F.lds;
        LAS float* red = (LAS float*)(F.lds + 16384);
        for (int i = F.tid_(); i < 2 * DM; i += 512) { const float v = a.c[i]; ca[i] = v * fsigmoid(v); }
        __syncthreads();
        float* MOD = (float*)(F.ws + WS_MOD);
        for (int it = bid_fresh(); it < 2 * 192; it += F.G) {
            const int l = it / 192, n = (it % 192) * 64 + F.lane_();
            const float* w = a.w_mod + (size_t)l * DM * 12288 + n;
            float a0 = 0.f, a1 = 0.f; const int kb = F.wave * 256;
#pragma unroll 8
            for (int k = 0; k < 256; ++k) { const float wv = w[(size_t)(kb + k) * 12288]; a0 += ca[kb + k] * wv; a1 += ca[DM + kb + k] * wv; }
            red[(F.wave * 2 + 0) * 64 + F.lane_()] = a0; red[(F.wave * 2 + 1) * 64 + F.lane_()] = a1;
            __syncthreads();
            if (F.tid_() < 128) { const int b = F.tid_() >> 6; float s = a.b_mod[l * 12288 + n];
#pragma unroll
                for (int w8 = 0; w8 < 8; ++w8) s += red[(w8 * 2 + b) * 64 + F.lane_()];
                MOD[(size_t)(l * 2 + b) * 12288 + n] = s; }
            __syncthreads();
        }
    }
    LAS float* scr = (LAS float*)(F.lds + F.wave * 16384);
    const int gw = bid_fresh() * 8 + F.wave, NGW = F.G * 8;
    constexpr int I_IN = 0, I_BR = 8 * 64, I_OUT = 32 * 64, I_G = 32 * 176, I_D = 88 * 64;
    constexpr int I_LAYER = I_IN + 4 * I_BR + I_OUT + I_D;
    for (int it = gw; it < DEPTH * I_LAYER; it += NGW) {
        const int l = it / I_LAYER; int r = it - l * I_LAYER;
        unsigned char* wl = F.ws + WS_W + (size_t)l * W_LAYER;
        if (r < I_IN) { const int kb = r / 152, nb = r % 152, c = nb * 32;
            transpose_item(a.w_in + (size_t)l * DM * INW, INW, c < 3072 ? c : c + 4, (bf16*)(wl + W_IN), DM, map_in_row(c), kb * 64, scr, F.lane_()); continue; }
        r -= I_IN;
        if (r < 4 * I_BR) { const int z = r / I_BR, q = r % I_BR, kb = q / 64, nb = q % 64;
            const float* src = (z == 0 ? a.w_br_a : z == 1 ? a.w_br_b : z == 2 ? a.w_br_c : a.w_br_d) + (size_t)l * 512 * DM;
            transpose_item(src, DM, nb * 32, (bf16*)(wl + W_BR) + z * 512, DM, nb * 32, kb * 64, scr, F.lane_()); continue; }
        r -= 4 * I_BR;
        if (r < I_OUT) { const int kb = r / 64, nb = r % 64;
            transpose_item(a.w_out + (size_t)l * DM * DM, DM, nb * 32, (bf16*)(wl + W_OUT), DM, nb * 32, kb * 64, scr, F.lane_()); continue; }
        r -= I_OUT;
        { const int kb = r / 64, nb = r % 64;
            transpose_item(a.w_down + (size_t)l * DFF * DM, DM, nb * 32, (bf16*)(wl + W_DN), DFF, nb * 32, kb * 64, scr, F.lane_()); }
    }
    {
        LAS float* cm = (LAS float*)(F.lds + RING_BYTES + 4096);
        LAS float* inv = cm + 256;
        const int lane = F.lane_();
        __syncthreads();
        for (int it = bid_fresh(); it < DEPTH * (2 * 176 + 408); it += F.G) {
            const int l = it / 760, q = it % 760;
            unsigned char* wl = F.ws + WS_W + (size_t)l * W_LAYER;
            const float* src; int ldw; unsigned char* dst; float* sc;
            if (q < 352) { const int up = q / 176, c0 = (q % 176) * 32, drow0 = 256 * (c0 >> 7) + (c0 & 127) + up * 128;
                src = (up ? a.w_up : a.w_gate) + (size_t)l * DM * DFF + c0; ldw = DFF; dst = wl + W_GU + (size_t)drow0 * DM; sc = (float*)(F.ws + WS_SW) + (size_t)l * 2 * DFF + drow0; }
            else { const int c = (q - 352) * 32, drow0 = c < 19 * 256 ? map_in_row(c) : c;
                src = a.w_in + (size_t)l * DM * INW + (c < 3072 ? c : c + 4); ldw = INW; dst = wl + W_IN + (size_t)drow0 * DM; sc = (float*)(F.ws + WS_SG) + (size_t)l * 13056 + drow0; }
            LAS unsigned char* s16 = (LAS unsigned char*)scr;
            f32x4 mx = {0.f, 0.f, 0.f, 0.f};
#pragma unroll 2
            for (int ch = 0; ch < 4; ++ch) { const int k0 = (F.wave * 4 + ch) * 64;
#pragma unroll
                for (int i = 0; i < 8; ++i) { const int kk = 8 * i + (lane >> 3); const f32x4 v = *(const f32x4*)(src + (size_t)(k0 + kk) * ldw + 4 * (lane & 7));
                    mx.x = fmaxf(mx.x, fabsf(v.x)); mx.y = fmaxf(mx.y, fabsf(v.y)); mx.z = fmaxf(mx.z, fabsf(v.z)); mx.w = fmaxf(mx.w, fabsf(v.w));
                    *(LAS u32x2*)(s16 + ch * 4096 + kk * 64 + 8 * (lane & 7)) = (u32x2){cvt_pk_bf16(v.x, v.y), cvt_pk_bf16(v.z, v.w)}; } }
#pragma unroll
            for (int e = 0; e < 4; ++e) { float t = mx[e]; t = fmaxf(t, shx<8>(t)); t = fmaxf(t, shx<16>(t)); t = fmaxf(t, shx<32>(t)); mx[e] = t; }
            if (lane < 8) *(LAS f32x4*)(cm + F.wave * 32 + 4 * lane) = mx;
            __syncthreads();
            { const int t = F.tid_(); if (t < 32) { float m8 = 1e-30f;
#pragma unroll
                for (int w = 0; w < 8; ++w) m8 = fmaxf(m8, cm[w * 32 + t]);
                inv[t] = 127.0f / m8; sc[t] = m8 * (1.0f / 127.0f); } }
            __syncthreads();
            { const int c = lane & 3;
#pragma unroll 1
                for (int ch = 0; ch < 4; ++ch) { const int k0 = (F.wave * 4 + ch) * 64;
#pragma unroll
                    for (int jj = 0; jj < 2; ++jj) { const int n = (lane >> 2) + 16 * jj; const LAS unsigned short* sp = (const LAS unsigned short*)(s16 + ch * 4096 + (16 * c) * 64 + n * 2); const float f = inv[n];
                        float e[16];
#pragma unroll
                        for (int i2 = 0; i2 < 16; ++i2) e[i2] = __builtin_bit_cast(float, (unsigned)sp[i2 * 32] << 16) * f;
                        u32x4 o; o.x = pk4_i8(e[0], e[1], e[2], e[3]); o.y = pk4_i8(e[4], e[5], e[6], e[7]); o.z = pk4_i8(e[8], e[9], e[10], e[11]); o.w = pk4_i8(e[12], e[13], e[14], e[15]);
                        *(GAS u32x4*)(dst + (size_t)n * DM + k0 + 16 * c) = o; } } }
            __syncthreads();
        }
    }
}

__device__ __forceinline__ void h2_scales(Frame& F, const Args& a) {
    LAS float* red = (LAS float*)(F.lds + RING_BYTES + 4096);
    const float* MOD = (const float*)(F.ws + WS_MOD);
    const int t = F.tid_(), lane = t & 63, c = 4 * t;
#pragma unroll
    for (int q = 0; q < 4; ++q) { const int l = q >> 1; const float* modq = MOD + (size_t)q * 12288;
        const f32x4 g = *(const f32x4*)(a.ffn_pre + l * DM + c), sc = *(const f32x4*)(modq + 8192 + c), sf = *(const f32x4*)(modq + 6144 + c);
        const f32x4 na = g * (sc + 1.0f);
        float sm = (na.x * na.x + na.y * na.y) + (na.z * na.z + na.w * na.w), mx = fmaxf(fmaxf(fabsf(sf.x), fabsf(sf.y)), fmaxf(fabsf(sf.z), fabsf(sf.w)));
        sm += shx<1>(sm); sm += shx<2>(sm); sm += shx<4>(sm); sm += shx<8>(sm); sm += shx<16>(sm); sm += shx<32>(sm);
        mx = fmaxf(mx, shx<1>(mx)); mx = fmaxf(mx, shx<2>(mx)); mx = fmaxf(mx, shx<4>(mx)); mx = fmaxf(mx, shx<8>(mx)); mx = fmaxf(mx, shx<16>(mx)); mx = fmaxf(mx, shx<32>(mx));
        if (lane == 0) { red[(q * 8 + F.wave) * 2] = sm; red[(q * 8 + F.wave) * 2 + 1] = mx; } }
    __syncthreads();
    if (t < 4) { float sm = 0.f, mx = 0.f;
#pragma unroll
        for (int w = 0; w < 8; ++w) { sm += red[(t * 8 + w) * 2]; mx = fmaxf(mx, red[(t * 8 + w) * 2 + 1]); }
        ((float*)(F.ws + WS_HS))[t] = (4.75f * sqrtf(sm * (1.0f / DM)) + mx) * (1.0f / 127.0f); }
    __syncthreads();
}

struct NormArgs {
    const float* xin; float* xout; const bf16* yo; bf16* hout; float* lf; unsigned char* h8; float* hr;
    const float* res_gate; const float* res_gain;
    const float* nx_gain; const float* nx_scale; const float* nx_shift;
    const float* wf; const float* fox_b;
    int flags;
};
__device__ __forceinline__ void norm_phase(Frame& F, const NormArgs& n) {
    const bool RES = n.flags & 1, NEXT = n.flags & 2, FG = n.flags & 4;
    const int tid = opaque_v(F.tid_()), lane = tid & 63, wave = __builtin_amdgcn_readfirstlane(tid >> 6);
    LAS f32x4* wfl = (LAS f32x4*)F.lds;
    LAS f32x4* pG1 = (LAS f32x4*)(F.lds + 32768);
    LAS f32x4* pNA = (LAS f32x4*)(F.lds + 40960);
    LAS f32x4* pNB = (LAS f32x4*)(F.lds + 49152);
    const int rows_per = M / (F.G * 8);
    const int b = (bid_fresh() * 8 * rows_per) / SEQ;
    if (FG) {
        for (int s = tid; s < DM; s += 512) { const int l = s & 63, ji = s >> 6, j = ji >> 2, i = ji & 3, c = 256 * j + 4 * l + i;
            wfl[s] = *(const f32x4*)(n.wf + (size_t)c * INW + 3072); }
    }
    { const int s = tid, c = 4 * s;
        if (RES) { const f32x4 g = *(const f32x4*)(n.res_gate + (size_t)b * 12288 + c), w = *(const f32x4*)(n.res_gain + c); pG1[s] = g * w; }
        if (NEXT) { const f32x4 g = *(const f32x4*)(n.nx_gain + c), sc = *(const f32x4*)(n.nx_scale + (size_t)b * 12288 + c); pNA[s] = g * (sc + 1.0f); pNB[s] = *(const f32x4*)(n.nx_shift + (size_t)b * 12288 + c); } }
    __syncthreads();
    const int gw = bid_fresh() * 8 + wave;
    const int row_lo = gw * rows_per;
    float fb[4] = {0.f, 0.f, 0.f, 0.f};
    if (FG) { fb[0] = n.fox_b[0]; fb[1] = n.fox_b[1]; fb[2] = n.fox_b[2]; fb[3] = n.fox_b[3]; }
    const bool XB = n.flags & 8;
    f32x4 nx[8]; u32x2 nxb[8], ny[8];
#define NORM_LOAD(row_) do { const size_t r_ = (size_t)(row_); \
        if (XB) { _Pragma("unroll") for (int j = 0; j < 8; ++j) nxb[j] = *(const u32x2*)((const bf16*)n.xin + r_ * (2 * DM) + DM + 256 * j + 4 * lane); } \
        else { _Pragma("unroll") for (int j = 0; j < 8; ++j) nx[j] = *(const f32x4*)(n.xin + r_ * DM + 256 * j + 4 * lane); } \
        if (RES) { _Pragma("unroll") for (int j = 0; j < 8; ++j) ny[j] = *(const u32x2*)(n.yo + r_ * DM + 256 * j + 4 * lane); } } while (0)
#pragma unroll
    for (int j = 0; j < 8; ++j) { nx[j] = (f32x4){0.f, 0.f, 0.f, 0.f}; nxb[j] = (u32x2){0u, 0u}; ny[j] = (u32x2){0u, 0u}; }
    NORM_LOAD(row_lo);
#pragma unroll 1
    for (int rr = 0; rr < rows_per; ++rr) {
        const size_t row = (size_t)(row_lo + rr);
        f32x4 v[8]; u32x2 y[8];
#pragma unroll
        for (int j = 0; j < 8; ++j) { v[j] = XB ? (f32x4){bf_lo(nxb[j].x), bf_hi(nxb[j].x), bf_lo(nxb[j].y), bf_hi(nxb[j].y)} : nx[j]; y[j] = ny[j]; }
        if (rr + 1 < rows_per) NORM_LOAD(row + 1);
        if (RES) {
            float ss = 0.f;
#pragma unroll
            for (int j = 0; j < 8; ++j) {
                const float y0 = bf_lo(y[j].x), y1 = bf_hi(y[j].x), y2 = bf_lo(y[j].y), y3 = bf_hi(y[j].y); ss += (y0 * y0 + y1 * y1) + (y2 * y2 + y3 * y3); }
            const float r = 1.0f / sqrtf(wave_sum(ss) * (1.0f / DM) + RMS_EPS);
#pragma unroll
            for (int j = 0; j < 8; ++j) { const f32x4 yy = (f32x4){bf_lo(y[j].x), bf_hi(y[j].x), bf_lo(y[j].y), bf_hi(y[j].y)};
                v[j] = v[j] + pG1[64 * j + lane] * (yy * r);
                if (n.flags & 16) { u32x2 w; w.x = cvt_pk_bf16(v[j].x, v[j].y); w.y = cvt_pk_bf16(v[j].z, v[j].w); *(u32x2*)((bf16*)n.xout + row * (2 * DM) + DM + 256 * j + 4 * lane) = w;
                    v[j] = (f32x4){bf_lo(w.x), bf_hi(w.x), bf_lo(w.y), bf_hi(w.y)}; }
                else *(f32x4*)(n.xout + row * DM + 256 * j + 4 * lane) = v[j]; }
        }
        if (NEXT) {
            float ss = 0.f;
#pragma unroll
            for (int j = 0; j < 8; ++j) ss += (v[j].x * v[j].x + v[j].y * v[j].y) + (v[j].z * v[j].z + v[j].w * v[j].w);
            const float r = 1.0f / sqrtf(wave_sum(ss) * (1.0f / DM) + RMS_EPS);
            float f0 = 0.f, f1 = 0.f, f2 = 0.f, f3 = 0.f, hmx = 1e-30f;
#pragma unroll
            for (int j = 0; j < 8; ++j) { const f32x4 h = (v[j] * r) * pNA[64 * j + lane] + pNB[64 * j + lane];
                if (n.hout) { u32x2 w; w.x = pk2(h.x, h.y); w.y = pk2(h.z, h.w); *(u32x2*)(n.hout + row * DM + 256 * j + 4 * lane) = w; }
                if (n.h8) { v[j] = h; hmx = fmaxf(hmx, fmaxf(fmaxf(fabsf(h.x), fabsf(h.y)), fmaxf(fabsf(h.z), fabsf(h.w)))); }
                if (FG) { const f32x4 w0 = wfl[(j * 4 + 0) * 64 + lane], w1 = wfl[(j * 4 + 1) * 64 + lane], w2 = wfl[(j * 4 + 2) * 64 + lane], w3 = wfl[(j * 4 + 3) * 64 + lane];
                    f0 += h.x * w0.x + h.y * w1.x + h.z * w2.x + h.w * w3.x; f1 += h.x * w0.y + h.y * w1.y + h.z * w2.y + h.w * w3.y;
                    f2 += h.x * w0.z + h.y * w1.z + h.z * w2.z + h.w * w3.z; f3 += h.x * w0.w + h.y * w1.w + h.z * w2.w + h.w * w3.w; }
                asm volatile("" ::: "memory"); }
            if (n.h8) {
                hmx = fmaxf(hmx, shx<1>(hmx)); hmx = fmaxf(hmx, shx<2>(hmx)); hmx = fmaxf(hmx, shx<4>(hmx)); hmx = fmaxf(hmx, shx<8>(hmx)); hmx = fmaxf(hmx, shx<16>(hmx)); hmx = fmaxf(hmx, shx<32>(hmx));
                const float qi = 127.0f / hmx;
                if (lane == 0) n.hr[row] = hmx * (1.0f / 127.0f);
#pragma unroll
                for (int j = 0; j < 8; ++j) *(unsigned*)(n.h8 + row * DM + 256 * j + 4 * lane) = pk4_i8(v[j].x * qi, v[j].y * qi, v[j].z * qi, v[j].w * qi); }
            if (FG) { f0 = wave_sum(f0); f1 = wave_sum(f1); f2 = wave_sum(f2); f3 = wave_sum(f3);
                if (lane == 0) { float z[4] = {f0 + fb[0], f1 + fb[1], f2 + fb[2], f3 + fb[3]}; f32x4 o;
#pragma unroll
                    for (int k = 0; k < 4; ++k) { const float t = z[k]; o[k] = fminf(t, 0.f) - log1pf(expf(-fabsf(t))); }
                    *(f32x4*)(n.lf + row * 4) = o; } }
        }
    }
#undef NORM_LOAD
    __syncthreads();
}
__device__ __forceinline__ void fox_scan(Frame& F, int bh) {
    const int tid = opaque_v(F.tid_()), lane = tid & 63, wave = __builtin_amdgcn_readfirstlane(tid >> 6);
    const int b = bh >> 2, hd = bh & 3; const float* lf = (const float*)(F.ws + WS_LF); float* kb = (float*)(F.ws + WS_KB) + (size_t)bh * SEQ;
    LAS float* wtot = (LAS float*)(F.lds + RING_BYTES + 64);
    float v[16]; float run = 0.f;
#pragma unroll
    for (int k = 0; k < 16; ++k) { run += lf[((size_t)b * SEQ + tid * 16 + k) * 4 + hd]; v[k] = run; }
    float inc = run;

    { float t; t = shup<1>(inc, lane); if (lane >= 1) inc += t; t = shup<2>(inc, lane); if (lane >= 2) inc += t; t = shup<4>(inc, lane); if (lane >= 4) inc += t; t = shup<8>(inc, lane); if (lane >= 8) inc += t; t = shup<16>(inc, lane); if (lane >= 16) inc += t; t = shup<32>(inc, lane); if (lane >= 32) inc += t; }
    if (lane == 63) wtot[wave] = inc;
    __syncthreads();
    float off = inc - run;
    for (int w = 0; w < wave; ++w) off += wtot[w];
#pragma unroll
    for (int k = 0; k < 16; ++k) kb[tid * 16 + k] = -(v[k] + off) * LOG2E;
    __syncthreads();
}

namespace att {
#define KSWZ(row, colB) ((row) * 256 + ((colB) ^ (((row) & 7) << 4)))
#define KSWZ64(row, colB) ((row) * 128 + ((colB) ^ (((row) & 7) << 4)))
#define SBAR() __builtin_amdgcn_sched_barrier(0)
__device__ __forceinline__ int crow(int r, int hi) { return (r & 3) + 8 * (r >> 2) + 4 * hi; }
template <int NC> __device__ __forceinline__ int v_st(int k, int c) { const int kk = (k & ~0xC) | ((k & 4) << 1) | ((k & 8) >> 1); return ((kk >> 3) * NC + (c >> 5)) * 512 + ((kk & 7) * 32 + (c & 31)) * 2; }
__device__ __forceinline__ int v_rd_base(int lane) { return ((lane & 3) << 3) | (((lane >> 2) & 3) << 6) | (((lane >> 4) & 1) << 5) | (((lane >> 5) & 1) << 8); }

__device__ __forceinline__ void softmax_tile(f32x16& p0, f32x16& p1, float& m_reg, float& l_reg, float& alpha, bf16x8& pa0, bf16x8& pa1, bf16x8& pa2, bf16x8& pa3) {
    float pmax = p0[0];
#pragma unroll
    for (int r = 1; r < 16; ++r) pmax = fmaxf(pmax, p0[r]);
#pragma unroll
    for (int r = 0; r < 16; ++r) pmax = fmaxf(pmax, p1[r]);
    { auto rr = __builtin_amdgcn_permlane32_swap(__float_as_uint(pmax), __float_as_uint(pmax), false, false);
      pmax = fmaxf(__uint_as_float(rr[0]), __uint_as_float(rr[1])); }
    const float mn = fmaxf(m_reg, pmax);
    alpha = __builtin_amdgcn_exp2f(m_reg - mn); m_reg = mn;
    float ps = 0.f;
#pragma unroll
    for (int r = 0; r < 16; ++r) { p0[r] = __builtin_amdgcn_exp2f(p0[r] - mn); ps += p0[r]; }
#pragma unroll
    for (int r = 0; r < 16; ++r) { p1[r] = __builtin_amdgcn_exp2f(p1[r] - mn); ps += p1[r]; }
    { auto rr = __builtin_amdgcn_permlane32_swap(__float_as_uint(ps), __float_as_uint(ps), false, false);
      ps = __uint_as_float(rr[0]) + __uint_as_float(rr[1]); }
    l_reg = l_reg * alpha + ps;
#define PK4(P, B_, OUT) do { unsigned a0 = cvt_pk_bf16(P[B_+0], P[B_+1]), a1 = cvt_pk_bf16(P[B_+2], P[B_+3]);                          \
        unsigned b0 = cvt_pk_bf16(P[B_+4], P[B_+5]), b1 = cvt_pk_bf16(P[B_+6], P[B_+7]);                                             \
        auto r0 = __builtin_amdgcn_permlane32_swap(a0, b0, false, false); auto r1 = __builtin_amdgcn_permlane32_swap(a1, b1, false, false); \
        u32x4 w = {r0[0], r1[0], r0[1], r1[1]}; OUT = __builtin_bit_cast(bf16x8, w); } while (0)
    PK4(p0, 0, pa0); PK4(p0, 8, pa1); PK4(p1, 0, pa2); PK4(p1, 8, pa3);
#undef PK4
}
__device__ __forceinline__ void qkt128(f32x16& p0, f32x16& p1, LAS const char* Kt, int r32, int hi, const bf16x8* qr) {
    LAS const char* kb[4];
#pragma unroll
    for (int dd = 0; dd < 4; ++dd) kb[dd] = Kt + KSWZ(r32, (dd * 16 + hi * 8) * 2);
#pragma unroll
    for (int d0 = 0; d0 < 8; ++d0) { LAS const char* a = kb[d0 & 3] + (d0 >> 2) * 128;
        const bf16x8 b0 = *(LAS const bf16x8*)a, b1 = *(LAS const bf16x8*)(a + 32 * 256);
        p0 = __builtin_amdgcn_mfma_f32_32x32x16_bf16(b0, qr[d0], p0, 0, 0, 0);
        p1 = __builtin_amdgcn_mfma_f32_32x32x16_bf16(b1, qr[d0], p1, 0, 0, 0); }
}
__device__ __forceinline__ void qkt64(f32x16& p0, f32x16& p1, LAS const char* Kt, int r32, int hi, const bf16x8* qr) {
#pragma unroll
    for (int d0 = 0; d0 < 4; ++d0) { LAS const char* a = Kt + KSWZ64(r32, (d0 * 16 + hi * 8) * 2);
        const bf16x8 b0 = *(LAS const bf16x8*)a, b1 = *(LAS const bf16x8*)(a + 32 * 128);
        p0 = __builtin_amdgcn_mfma_f32_32x32x16_bf16(b0, qr[d0], p0, 0, 0, 0);
        p1 = __builtin_amdgcn_mfma_f32_32x32x16_bf16(b1, qr[d0], p1, 0, 0, 0); }
}
template <int ND0>
__device__ __forceinline__ void pv_tile(f32x16* o, int vb, bf16x8 pa0, bf16x8 pa1, bf16x8 pa2, bf16x8 pa3) {
    constexpr int KS = ND0 * 1024, HF = ND0 * 512;
#define TRRD(dst, off) asm volatile("ds_read_b64_tr_b16 %0, %1 offset:%2" : "=&v"(dst) : "v"(vb), "i"(off) : "memory")
#define PV_D0(d0) do { s16x4 l0, l1, l2, l3, h0, h1, h2, h3; constexpr int b_ = (d0) * 512; \
        TRRD(l0, b_); TRRD(h0, b_ + HF); TRRD(l1, b_ + KS); TRRD(h1, b_ + KS + HF); TRRD(l2, b_ + 2 * KS); TRRD(h2, b_ + 2 * KS + HF); TRRD(l3, b_ + 3 * KS); TRRD(h3, b_ + 3 * KS + HF); \
        asm volatile("s_waitcnt lgkmcnt(0)" ::: "memory"); SBAR(); \
        o[d0] = __builtin_amdgcn_mfma_f32_32x32x16_bf16(pa0, (bf16x8){l0[0], l0[1], l0[2], l0[3], h0[0], h0[1], h0[2], h0[3]}, o[d0], 0, 0, 0); \
        o[d0] = __builtin_amdgcn_mfma_f32_32x32x16_bf16(pa1, (bf16x8){l1[0], l1[1], l1[2], l1[3], h1[0], h1[1], h1[2], h1[3]}, o[d0], 0, 0, 0); \
        o[d0] = __builtin_amdgcn_mfma_f32_32x32x16_bf16(pa2, (bf16x8){l2[0], l2[1], l2[2], l2[3], h2[0], h2[1], h2[2], h2[3]}, o[d0], 0, 0, 0); \
        o[d0] = __builtin_amdgcn_mfma_f32_32x32x16_bf16(pa3, (bf16x8){l3[0], l3[1], l3[2], l3[3], h3[0], h3[1], h3[2], h3[3]}, o[d0], 0, 0, 0); } while (0)
    PV_D0(0); PV_D0(1);
    if constexpr (ND0 == 4) { PV_D0(2); PV_D0(3); }
#undef PV_D0
#undef TRRD
}
template <int ND0>
__device__ __forceinline__ void store_o(const f32x16* o, float l_reg, LAS float* li_l, bf16* Ow, int r32, int hi) {
    if (hi == 0) li_l[r32] = l_reg;
    LDS_WAIT();
    float rli[16];
#pragma unroll
    for (int r = 0; r < 16; ++r) rli[r] = __builtin_amdgcn_rcpf(li_l[crow(r, hi)]);
#pragma unroll
    for (int r = 0; r < 16; ++r) { const int orow = crow(r, hi);
#pragma unroll
        for (int d0 = 0; d0 < ND0; ++d0) { const float v = o[d0][r] * rli[r]; const float vn = shx<1>(v);
            if ((r32 & 1) == 0) *(unsigned*)(Ow + (size_t)orow * DM + d0 * 32 + r32) = cvt_pk_bf16(v, vn); } }
}
#define RESC(ND0) do { if (__any(alpha < 1.f)) { if (hi == 0) al_l[r32] = alpha; LDS_WAIT(); \
        _Pragma("unroll") for (int d_ = 0; d_ < (ND0); ++d_) _Pragma("unroll") for (int r = 0; r < 16; ++r) o[d_][r] *= al_l[crow(r, hi)]; } } while (0)

constexpr int A_V = 0, A_K = 32768, A_WS = 65536, A_KB = 67584, A_LUT = 68096, A_MISC = 74752;

template <int KIND>
__device__ __forceinline__ void attn128_unit(Frame& F, const Args& a, int l, int b, int h, int qb) {
    const int tid = opaque_v(F.tid_()), wid = __builtin_amdgcn_readfirstlane(tid >> 6), lane = tid & 63, r32 = lane & 31, hi = lane >> 5;
    LAS char* lds = (LAS char*)F.lds;
    LAS char* V_lds = lds + A_V; LAS char* K_lds = lds + A_K;
    LAS float* wsf = (LAS float*)(lds + A_WS) + wid * 64; LAS float* li_l = wsf; LAS float* al_l = wsf + 32;
    LAS float* kbuf = (LAS float*)(lds + A_KB);
    LAS float* lut = (LAS float*)(lds + A_LUT);
    LAS unsigned* bw = (LAS unsigned*)(lds + A_MISC);
    const bf16* PJ = (const bf16*)(F.ws + WS_PJ);
    const int q0 = qb * 256, qlo = q0 + wid * 32, qpos = qlo + r32;
    const size_t rowb = (size_t)b * SEQ;
    const bf16* Qp = PJ + (rowb + qpos) * LDP + (KIND == 0 ? PJ_BQ : PJ_AQ) + h * 128;
    const bf16* Kp = PJ + rowb * LDP + (KIND == 0 ? PJ_BK : PJ_AK) + h * 128;
    const bf16* Vp = PJ + rowb * LDP + (KIND == 0 ? PJ_BV : PJ_AV) + h * 128;
    const float* kbg = (const float*)(F.ws + WS_KB) + (size_t)(b * 4 + h) * SEQ;
    bf16x8 qr[8];
#pragma unroll
    for (int d0 = 0; d0 < 8; ++d0) qr[d0] = *(const bf16x8*)(Qp + d0 * 16 + hi * 8);
    const int sr = tid >> 4, sc = (tid & 15) * 8, vst0 = v_st<4>(sr, sc), vst1 = v_st<4>(32 + sr, sc), kws = KSWZ(sr, sc * 2);
    const int vb0 = (int)(unsigned)(size_t)V_lds + v_rd_base(lane);
    unsigned selmask = 0u; unsigned blkmask = 0u; float c31 = 0.f;
    if constexpr (KIND == 1) {
        const int own = qb;
        for (int i = tid; i < 1408; i += 512) { const int d = i - 128; lut[i] = d < 0 ? -__builtin_inff() : a.rel_bias[t5_bucket(d) * 12 + h] * LOG2E; }
        c31 = a.rel_bias[31 * 12 + h] * LOG2E;
        if (own > 0) {
            const float* km = (const float*)(F.ws + WS_CTL + CTL_KMEAN) + (size_t)l * 64 * 512 + (size_t)(b * 32 + sr) * 512 + h * 128 + sc;
            const f32x4 m0 = *(const f32x4*)km * (1.0f / 256.0f), m1 = *(const f32x4*)(km + 4) * (1.0f / 256.0f);
            u32x4 wh, wl; float e[8] = {m0.x, m0.y, m0.z, m0.w, m1.x, m1.y, m1.z, m1.w}; unsigned hh[8], ll[8];
#pragma unroll
            for (int k = 0; k < 8; ++k) { hh[k] = f2bf(e[k]); ll[k] = f2bf(e[k] - __builtin_bit_cast(float, hh[k] << 16)); }
            wh = (u32x4){hh[0] | (hh[1] << 16), hh[2] | (hh[3] << 16), hh[4] | (hh[5] << 16), hh[6] | (hh[7] << 16)};
            wl = (u32x4){ll[0] | (ll[1] << 16), ll[2] | (ll[3] << 16), ll[4] | (ll[5] << 16), ll[6] | (ll[7] << 16)};
            *(LAS u32x4*)(K_lds + kws) = wh; *(LAS u32x4*)(K_lds + kws + 32 * 256) = wl;
            __syncthreads();
            f32x16 s0 = {}, s1 = {};
            qkt128(s0, s1, K_lds, r32, hi, qr);
            float v1 = -__builtin_inff(), v2 = v1, v3 = v1; int i1 = 0, i2 = 0, i3 = 0;
#define INS(x, j) do { const float x_ = (x); const int j_ = (j); if (x_ > v1) { v3 = v2; i3 = i2; v2 = v1; i2 = i1; v1 = x_; i1 = j_; } else if (x_ > v2) { v3 = v2; i3 = i2; v2 = x_; i2 = j_; } else if (x_ > v3) { v3 = x_; i3 = j_; } } while (0)
#pragma unroll
            for (int r = 0; r < 16; ++r) { const int j = crow(r, hi); const float x = (j < own) ? (s0[r] + s1[r]) : -__builtin_inff(); INS(x, j); }
            const float w1 = shx<32>(v1), w2 = shx<32>(v2), w3 = shx<32>(v3);
            const int j1 = shx<32>(i1), j2 = shx<32>(i2), j3 = shx<32>(i3);
            INS(w1, j1); INS(w2, j2); INS(w3, j3);
#undef INS
            if (v1 > -__builtin_inff()) selmask |= 1u << i1;
            if (v2 > -__builtin_inff()) selmask |= 1u << i2;
            if (v3 > -__builtin_inff()) selmask |= 1u << i3;
            unsigned um = selmask;

            { um |= shx<1>(um); um |= shx<2>(um); um |= shx<4>(um); um |= shx<8>(um); um |= shx<16>(um); um |= shx<32>(um); }
            if (lane == 0) bw[wid] = um;
            __syncthreads();
            um = 0u;
#pragma unroll
            for (int w = 0; w < 8; ++w) um |= bw[w];
            blkmask = (unsigned)__builtin_amdgcn_readfirstlane((int)um);
        } else { __syncthreads(); }
        selmask |= 1u << own; blkmask |= 1u << own;
    }
    float m_reg = -1e30f, l_reg = 0.f, alpha; f32x16 o[4] = {};
    bf16x8 st_k0, st_k1, st_v0, st_v1; float st_kb = 0.f;
    float rowbound = 0.f; LAS unsigned* vote = bw + 16;
    if constexpr (KIND == 0) {
        float qq = 0.f;
#pragma unroll
        for (int d0 = 0; d0 < 8; ++d0) { const u32x4 w = __builtin_bit_cast(u32x4, qr[d0]);
            qq += (bf_lo(w.x) * bf_lo(w.x) + bf_hi(w.x) * bf_hi(w.x)) + (bf_lo(w.y) * bf_lo(w.y) + bf_hi(w.y) * bf_hi(w.y)) + (bf_lo(w.z) * bf_lo(w.z) + bf_hi(w.z) * bf_hi(w.z)) + (bf_lo(w.w) * bf_lo(w.w) + bf_hi(w.w) * bf_hi(w.w)); }
        qq += shx<32>(qq);
        const float kn2v = __uint_as_float(__hip_atomic_load((const unsigned*)(F.ws + WS_CTL) + CW_KN2 + (l * 8 + b * 4 + h) * 64, RLX_AGENT));
        rowbound = sqrtf(qq) * (2.0f * sqrtf(kn2v)) * 1.02f;
    }
#define LOADT(k0_) do { const bf16* kp_ = Kp + (size_t)((k0_) + sr) * LDP + sc; const bf16* vp_ = Vp + (size_t)((k0_) + sr) * LDP + sc; \
        st_k0 = *(const bf16x8*)kp_; st_k1 = *(const bf16x8*)(kp_ + (size_t)32 * LDP); st_v0 = *(const bf16x8*)vp_; st_v1 = *(const bf16x8*)(vp_ + (size_t)32 * LDP); \
        if (KIND == 0 && tid < 64) st_kb = kbg[(k0_) + tid]; } while (0)
#define WRITET(bf_) do { *(LAS bf16x8*)(K_lds + (bf_) * 16384 + kws) = st_k0; *(LAS bf16x8*)(K_lds + (bf_) * 16384 + kws + 32 * 256) = st_k1; \
        *(LAS bf16x8*)(V_lds + (bf_) * 16384 + vst0) = st_v0; *(LAS bf16x8*)(V_lds + (bf_) * 16384 + vst1) = st_v1; \
        if (KIND == 0 && tid < 64) kbuf[(bf_) * 64 + tid] = st_kb; } while (0)
    int k0; unsigned rem = 0u;
    if constexpr (KIND == 0) { k0 = q0 + 192; }
    else { rem = blkmask; const int jb = __builtin_ctz(rem); rem &= rem - 1u; k0 = jb * 256; }
    int buf = 0;
    LOADT(k0); WRITET(0);
    __syncthreads();
    for (;;) {
        int kn;
        if constexpr (KIND == 0) { kn = k0 - 64; }
        else { if ((k0 & 255) != 192) kn = k0 + 64; else if (rem) { const int jb = __builtin_ctz(rem); rem &= rem - 1u; kn = jb * 256; } else kn = -1; }
        if (kn >= 0) LOADT(kn);
        float kbprev = 0.f; if (KIND == 0 && k0 > 0) kbprev = kbg[k0 - 1];
        bool act = (k0 <= qlo + 31);
        bool sel = true;
        if constexpr (KIND == 1) { sel = (selmask >> (k0 >> 8)) & 1u; act = act && __any(sel); }
        if (act) {
            f32x16 p0, p1;
            if constexpr (KIND == 0) {
                LAS const float* kb_ = kbuf + buf * 64 + 4 * hi;
#pragma unroll
                for (int g = 0; g < 4; ++g) { const f32x4 x0 = *(LAS const f32x4*)(kb_ + 8 * g), x1 = *(LAS const f32x4*)(kb_ + 32 + 8 * g);
                    p0[4 * g] = x0.x; p0[4 * g + 1] = x0.y; p0[4 * g + 2] = x0.z; p0[4 * g + 3] = x0.w; p1[4 * g] = x1.x; p1[4 * g + 1] = x1.y; p1[4 * g + 2] = x1.z; p1[4 * g + 3] = x1.w; }
                if (k0 + 63 > qlo) {
                    const int dq = qpos - k0 - 4 * hi;
#pragma unroll
                    for (int r = 0; r < 16; ++r) { const int c = (r & 3) + 8 * (r >> 2); if (dq - c < 0) p0[r] = -__builtin_inff(); if (dq - c - 32 < 0) p1[r] = -__builtin_inff(); }
                }
            } else {
                const float NEG = -__builtin_inff();
                if (q0 - (k0 + 63) >= 790) {
                    const float v = sel ? c31 : NEG;
#pragma unroll
                    for (int r = 0; r < 16; ++r) { p0[r] = v; p1[r] = v; }
                } else {
                    LAS const float* lp = lut + 128 + (qpos - k0 - 4 * hi) - 63;
#pragma unroll
                    for (int r = 0; r < 16; ++r) { const int c = (r & 3) + 8 * (r >> 2); const float x0 = lp[63 - c], x1 = lp[31 - c]; p0[r] = sel ? x0 : NEG; p1[r] = sel ? x1 : NEG; }
                }
            }
            qkt128(p0, p1, K_lds + buf * 16384, r32, hi, qr);
            bf16x8 pa0, pa1, pa2, pa3;
            softmax_tile(p0, p1, m_reg, l_reg, alpha, pa0, pa1, pa2, pa3);
            RESC(4);
            pv_tile<4>(o, vb0 + buf * 16384, pa0, pa1, pa2, pa3);
        }
        if (kn >= 0) WRITET(buf ^ 1);
        if constexpr (KIND == 0) { const bool done = __all(rowbound + kbprev - m_reg < -40.0f); if (lane == 0) vote[buf * 8 + wid] = done ? 1u : 0u; }
        __syncthreads();
        if (kn < 0) break;
        if constexpr (KIND == 0) { unsigned v = 1u;
#pragma unroll
            for (int w = 0; w < 8; ++w) v &= vote[buf * 8 + w];
            if (__builtin_amdgcn_readfirstlane((int)v)) break; }
        k0 = kn; buf ^= 1;
    }
#undef LOADT
#undef WRITET
    bf16* Ow = (bf16*)(F.ws + WS_BR) + (rowb + qlo) * DM + (KIND == 0 ? 512 : 0) + h * 128 + 0;
    store_o<4>(o, l_reg, li_l, Ow, r32, hi);
    __syncthreads();
}

constexpr int M_LUT = 131584, M_BINS = 137216, M_SEL = 145408, M_CNT = 146432, M_TASK = 146560, M_NT = 146816, M_ML = 146832, M_WS = 155024;
static_assert(M_WS + 8 * 256 <= LDS_BYTES, "MoBA LDS map");
__device__ __forceinline__ void moba_unit(Frame& F, const Args& a, int l, int b, int h, int own) {
    const int tid = opaque_v(F.tid_()), wid = __builtin_amdgcn_readfirstlane(tid >> 6), lane = tid & 63, r32 = lane & 31, hi = lane >> 5;
    LAS char* lds = (LAS char*)F.lds;
    LAS float* lut = (LAS float*)(lds + M_LUT);
    LAS unsigned char* bins = (LAS unsigned char*)(lds + M_BINS);
    LAS unsigned* selw = (LAS unsigned*)(lds + M_SEL);
    LAS unsigned* cnt = (LAS unsigned*)(lds + M_CNT);
    LAS unsigned short* tasks = (LAS unsigned short*)(lds + M_TASK);
    LAS unsigned* ntp = (LAS unsigned*)(lds + M_NT);
    LAS f32x2* ml = (LAS f32x2*)(lds + M_ML);
    LAS float* al_l = (LAS float*)(lds + M_WS) + wid * 64; LAS int* qix = (LAS int*)(al_l + 32);
    LAS char* vreg = lds + wid * 16384;
    const bf16* PJ = (const bf16*)(F.ws + WS_PJ);
    const int q0 = own * 256; const size_t rowb = (size_t)b * SEQ;
    const bf16* Qb = PJ + (rowb + q0) * LDP + PJ_AQ + h * 128;
    const bf16* KFb = (const bf16*)(F.ws + WS_KF) + (size_t)(b * 4 + h) * 256 * 8 * 2 * 32 * 8;
    const bf16* VFb = (const bf16*)(F.ws + WS_VF) + (size_t)(b * 4 + h) * 512 * 4 * 2 * 32 * 8;
    bf16* part = (bf16*)(F.ws + WS_HY) + (size_t)bid_fresh() * (4 * 256 * 128);
    for (int i = tid; i < 1408; i += 512) { const int d = i - 128; lut[i] = d < 0 ? -__builtin_inff() : a.rel_bias[t5_bucket(d) * 12 + h] * LOG2E; }
    unsigned selmask = 0u;
    if (own > 0) {
        const int sr = tid >> 4, sc = (tid & 15) * 8, kws = KSWZ(sr, sc * 2);
        const float* km = (const float*)(F.ws + WS_CTL + CTL_KMEAN) + (size_t)l * 64 * 512 + (size_t)(b * 32 + sr) * 512 + h * 128 + sc;
        const f32x4 m0 = *(const f32x4*)km * (1.0f / 256.0f), m1 = *(const f32x4*)(km + 4) * (1.0f / 256.0f);
        float e[8] = {m0.x, m0.y, m0.z, m0.w, m1.x, m1.y, m1.z, m1.w}; unsigned hh[8], ll[8];
#pragma unroll
        for (int k = 0; k < 8; ++k) { hh[k] = f2bf(e[k]); ll[k] = f2bf(e[k] - __builtin_bit_cast(float, hh[k] << 16)); }
        *(LAS u32x4*)(lds + kws) = (u32x4){hh[0] | (hh[1] << 16), hh[2] | (hh[3] << 16), hh[4] | (hh[5] << 16), hh[6] | (hh[7] << 16)};
        *(LAS u32x4*)(lds + kws + 32 * 256) = (u32x4){ll[0] | (ll[1] << 16), ll[2] | (ll[3] << 16), ll[4] | (ll[5] << 16), ll[6] | (ll[7] << 16)};
        bf16x8 qn[8];
#pragma unroll
        for (int d0 = 0; d0 < 8; ++d0) qn[d0] = *(const bf16x8*)(Qb + (size_t)(wid * 32 + r32) * LDP + d0 * 16 + hi * 8);
        __syncthreads();
        f32x16 s0 = {}, s1 = {};
        qkt128(s0, s1, lds, r32, hi, qn);
        float v1 = -__builtin_inff(), v2 = v1, v3 = v1; int i1 = 0, i2 = 0, i3 = 0;
#define INS(x, j) do { const float x_ = (x); const int j_ = (j); if (x_ > v1) { v3 = v2; i3 = i2; v2 = v1; i2 = i1; v1 = x_; i1 = j_; } else if (x_ > v2) { v3 = v2; i3 = i2; v2 = x_; i2 = j_; } else if (x_ > v3) { v3 = x_; i3 = j_; } } while (0)
#pragma unroll
        for (int r = 0; r < 16; ++r) { const int j = crow(r, hi); const float x = (j < own) ? (s0[r] + s1[r]) : -__builtin_inff(); INS(x, j); }
        const float w1 = shx<32>(v1), w2 = shx<32>(v2), w3 = shx<32>(v3);
        const int j1 = shx<32>(i1), j2 = shx<32>(i2), j3 = shx<32>(i3);
        INS(w1, j1); INS(w2, j2); INS(w3, j3);
#undef INS
        if (v1 > -__builtin_inff()) selmask |= 1u << i1;
        if (v2 > -__builtin_inff()) selmask |= 1u << i2;
        if (v3 > -__builtin_inff()) selmask |= 1u << i3;
    }
    if (hi == 0) selw[wid * 32 + r32] = selmask;
    LAS unsigned char* wcnt = (LAS unsigned char*)(lds + M_TASK);
    for (int j = 0; j < own; ++j) { const unsigned long long bal = __ballot(hi == 0 && ((selmask >> j) & 1u)); if (lane == 0) wcnt[wid * 32 + j] = (unsigned char)__builtin_popcountll(bal); }
    __syncthreads();
    if (tid < 32) { unsigned c = 0; for (int w = 0; w < 8; ++w) c += wcnt[w * 32 + tid]; cnt[tid] = tid < own ? c : 0u; }
    for (int j = 0; j < own; ++j) { const bool mine = hi == 0 && ((selmask >> j) & 1u); const unsigned long long bal = __ballot(mine);
        if (mine) { unsigned pos = (unsigned)__builtin_popcountll(bal & ((1ull << lane) - 1ull)); for (int w = 0; w < wid; ++w) pos += wcnt[w * 32 + j]; bins[j * 256 + pos] = (unsigned char)(wid * 32 + r32); } }
    __syncthreads();
    if (tid == 0) { unsigned n = 0; for (int j = 0; j < own; ++j) { const unsigned c = (cnt[j] + 31u) >> 5; for (unsigned k = 0; k < c; ++k) tasks[n++] = (unsigned short)(j | (k << 8)); } ntp[0] = n; }
    __syncthreads();
    const int nt = (int)ntp[0];
    const int vb0 = (int)(unsigned)(size_t)vreg + v_rd_base(lane);
#pragma unroll 1
    for (int k = wid; k < nt + 8; k += 8) {
        int j, qi, slot, ktn; bool valid = true;
        if (k < nt) { const unsigned tk = tasks[k]; j = tk & 255; const int idx = (int)(tk >> 8) * 32 + r32; valid = idx < (int)cnt[j];
            qi = bins[j * 256 + (valid ? idx : 0)]; const unsigned sm = selw[qi]; slot = __builtin_popcount(sm & ((1u << j) - 1u)); ktn = 4; }
        else { const int g = k - nt; j = own; qi = g * 32 + r32; slot = 3; ktn = (g >> 1) + 1; }
        const int t = q0 + qi;
        bf16x8 qr[8];
#pragma unroll
        for (int d0 = 0; d0 < 8; ++d0) qr[d0] = *(const bf16x8*)(Qb + (size_t)qi * LDP + d0 * 16 + hi * 8);
        if (hi == 0) qix[r32] = valid ? (qi | (slot << 8)) : -1;
        float m_reg = -1e30f, l_reg = 0.f, alpha; f32x16 o[4] = {};
        const bf16* kpb = KFb + ((size_t)(j * 8) * 8 * 2 * 32 + hi * 32 + r32) * 8;
        const bf16* vpb = VFb + ((size_t)(j * 16) * 4 * 2 * 32 + hi * 32 + r32) * 8;
#pragma unroll 1
        for (int kt = 0; kt < ktn; ++kt) {
            const int k0 = j * 256 + kt * 64;
            const bf16* kp = kpb + (size_t)(kt * 2) * 8 * 512;
            const bf16* vp = vpb + (size_t)(kt * 4) * 4 * 512;
            bf16x8 kA0[4], kA1[4], kB0[4], kB1[4], vA[8], vB[8];
#pragma unroll
            for (int d = 0; d < 4; ++d) { kA0[d] = *(const bf16x8*)(kp + d * 512); kA1[d] = *(const bf16x8*)(kp + (8 + d) * 512); }
#pragma unroll
            for (int d = 0; d < 4; ++d) { kB0[d] = *(const bf16x8*)(kp + (4 + d) * 512); kB1[d] = *(const bf16x8*)(kp + (12 + d) * 512); }
#pragma unroll
            for (int i = 0; i < 8; ++i) vA[i] = *(const bf16x8*)(vp + i * 512);
            int dq = t - k0 - 4 * hi; dq = dq > 1100 ? 1100 : dq;
            LAS const float* lp = lut + 128 + dq - 63;
            f32x16 p0, p1;
#pragma unroll
            for (int r = 0; r < 16; ++r) { const int c = (r & 3) + 8 * (r >> 2); p0[r] = lp[63 - c]; p1[r] = lp[31 - c]; }
#pragma unroll
            for (int d = 0; d < 4; ++d) { p0 = __builtin_amdgcn_mfma_f32_32x32x16_bf16(kA0[d], qr[d], p0, 0, 0, 0); p1 = __builtin_amdgcn_mfma_f32_32x32x16_bf16(kA1[d], qr[d], p1, 0, 0, 0); }
#pragma unroll
            for (int d = 0; d < 4; ++d) { p0 = __builtin_amdgcn_mfma_f32_32x32x16_bf16(kB0[d], qr[4 + d], p0, 0, 0, 0); p1 = __builtin_amdgcn_mfma_f32_32x32x16_bf16(kB1[d], qr[4 + d], p1, 0, 0, 0); }
            asm volatile("" ::: "memory");
#pragma unroll
            for (int i = 0; i < 8; ++i) vB[i] = *(const bf16x8*)(vp + (8 + i) * 512);
            bf16x8 pa0, pa1, pa2, pa3;
            softmax_tile(p0, p1, m_reg, l_reg, alpha, pa0, pa1, pa2, pa3);
            if (__any(alpha < 1.f)) { if (hi == 0) al_l[r32] = alpha; LDS_WAIT();
#pragma unroll
                for (int d_ = 0; d_ < 4; ++d_)
#pragma unroll
                    for (int r = 0; r < 16; ++r) o[d_][r] *= al_l[crow(r, hi)]; }
#pragma unroll
            for (int d0 = 0; d0 < 4; ++d0) { o[d0] = __builtin_amdgcn_mfma_f32_32x32x16_bf16(pa0, vA[d0], o[d0], 0, 0, 0); o[d0] = __builtin_amdgcn_mfma_f32_32x32x16_bf16(pa1, vA[4 + d0], o[d0], 0, 0, 0); }
#pragma unroll
            for (int d0 = 0; d0 < 4; ++d0) { o[d0] = __builtin_amdgcn_mfma_f32_32x32x16_bf16(pa2, vB[d0], o[d0], 0, 0, 0); o[d0] = __builtin_amdgcn_mfma_f32_32x32x16_bf16(pa3, vB[4 + d0], o[d0], 0, 0, 0); }
        }
        if (hi == 0) { al_l[r32] = l_reg; if (valid) ml[slot * 256 + qi] = (f32x2){m_reg, l_reg}; }
        LDS_WAIT();
#pragma unroll
        for (int r = 0; r < 16; ++r) { const int rr = crow(r, hi); const int qrow = qix[rr]; const float rl = __builtin_amdgcn_rcpf(al_l[rr]);
            bf16* prow = part + ((size_t)(qrow < 0 ? 0 : (qrow >> 8)) * 256 + (qrow < 0 ? 0 : (qrow & 255))) * 128;
#pragma unroll
            for (int d0 = 0; d0 < 4; ++d0) { const float v = o[d0][r] * rl; const float vn = shx<1>(v);
                if ((r32 & 1) == 0 && qrow >= 0) *(unsigned*)(prow + d0 * 32 + r32) = cvt_pk_bf16(v, vn); } }
    }
    VM_WAIT();
    __syncthreads();
    __builtin_amdgcn_fence(__ATOMIC_ACQUIRE, "agent");
    { const int q = tid >> 1, hf = tid & 1; const unsigned sm = selw[q]; const int ns = __builtin_popcount(sm);
        float ms[4], ls[4]; float Mx = -1e30f;
#pragma unroll
        for (int s_ = 0; s_ < 4; ++s_) { const bool on = (s_ == 3) || (s_ < ns); const f32x2 v = on ? ml[s_ * 256 + q] : (f32x2){-1e30f, 0.f}; ms[s_] = v.x; ls[s_] = v.y; Mx = fmaxf(Mx, v.x); }
        float wsum = 0.f, wgt[4];
#pragma unroll
        for (int s_ = 0; s_ < 4; ++s_) { wgt[s_] = ls[s_] * __builtin_amdgcn_exp2f(ms[s_] - Mx); wsum += wgt[s_]; }
        const float rw = 1.0f / wsum;
        float accv[64];
#pragma unroll
        for (int i = 0; i < 64; ++i) accv[i] = 0.f;
#pragma unroll
        for (int s_ = 0; s_ < 4; ++s_) { if (wgt[s_] > 0.f) { const float w = wgt[s_] * rw; const u32x4* src = (const u32x4*)(part + ((size_t)s_ * 256 + q) * 128 + hf * 64);
#pragma unroll
                for (int c8 = 0; c8 < 8; ++c8) { const u32x4 x = src[c8];
                    accv[c8 * 8 + 0] += w * bf_lo(x.x); accv[c8 * 8 + 1] += w * bf_hi(x.x); accv[c8 * 8 + 2] += w * bf_lo(x.y); accv[c8 * 8 + 3] += w * bf_hi(x.y);
                    accv[c8 * 8 + 4] += w * bf_lo(x.z); accv[c8 * 8 + 5] += w * bf_hi(x.z); accv[c8 * 8 + 6] += w * bf_lo(x.w); accv[c8 * 8 + 7] += w * bf_hi(x.w); } } }
        u32x4* dst = (u32x4*)((bf16*)(F.ws + WS_BR) + (rowb + q0 + q) * DM + h * 128 + hf * 64);
#pragma unroll
        for (int c8 = 0; c8 < 8; ++c8) { u32x4 o4; o4.x = cvt_pk_bf16(accv[c8 * 8 + 0], accv[c8 * 8 + 1]); o4.y = cvt_pk_bf16(accv[c8 * 8 + 2], accv[c8 * 8 + 3]);
            o4.z = cvt_pk_bf16(accv[c8 * 8 + 4], accv[c8 * 8 + 5]); o4.w = cvt_pk_bf16(accv[c8 * 8 + 6], accv[c8 * 8 + 7]); dst[c8] = o4; } }
    __syncthreads();
}

__device__ __forceinline__ void swa_unit(Frame& F, const Args& a, int l, int b, int kvh, int nb) {
    const int tid = opaque_v(F.tid_()), wid = __builtin_amdgcn_readfirstlane(tid >> 6), lane = tid & 63, r32 = lane & 31, hi = lane >> 5;
    LAS char* lds = (LAS char*)F.lds;
    LAS char* V_lds = lds + A_V; LAS char* K_lds = lds + A_K;
    LAS float* wsf = (LAS float*)(lds + A_WS) + wid * 64; LAS float* li_l = wsf; LAS float* al_l = wsf + 32;
    LAS float* lut = (LAS float*)(lds + A_LUT);
    const bf16* PJ = (const bf16*)(F.ws + WS_PJ);
    const int T0 = nb * 128; const size_t rowb = (size_t)b * SEQ;
    const int g = wid >> 1, half = wid & 1, head = kvh * 4 + g;
    for (int i = tid; i < 4 * 384; i += 512) { const int gg = i / 384, d = (i % 384) - 128;
        lut[i] = (d < 0 || d >= 128) ? -__builtin_inff() : a.rel_bias[t5_bucket(d) * 12 + 4 + kvh * 4 + gg] * LOG2E; }
    { const int sr = tid >> 3, sc = (tid & 7) * 8;
#pragma unroll
      for (int kt = 0; kt < 4; ++kt) { const int k0 = T0 - 128 + 64 * kt; if (k0 < 0) continue;
          const bf16* kp = PJ + (rowb + k0 + sr) * LDP + PJ_DK + kvh * 64 + sc; const bf16* vp = PJ + (rowb + k0 + sr) * LDP + PJ_DV + kvh * 64 + sc;
          const bf16x8 kk = *(const bf16x8*)kp, vv = *(const bf16x8*)vp;
          *(LAS bf16x8*)(K_lds + kt * 8192 + KSWZ64(sr, sc * 2)) = kk; *(LAS bf16x8*)(V_lds + kt * 8192 + v_st<2>(sr, sc)) = vv; } }
    __syncthreads();
    const float sinkv = a.sinks[l * 8 + head] * LOG2E;
    const int vb0 = (int)(unsigned)(size_t)V_lds + v_rd_base(lane);
#pragma unroll 1
    for (int qg = 0; qg < 2; ++qg) {
        const int r0 = T0 + 64 * half + 32 * qg, qpos = r0 + r32;
        const bf16* Qp = PJ + (rowb + qpos) * LDP + PJ_DQ + head * 64;
        bf16x8 qr[4];
#pragma unroll
        for (int d0 = 0; d0 < 4; ++d0) qr[d0] = *(const bf16x8*)(Qp + d0 * 16 + hi * 8);
        float m_reg = sinkv, l_reg = 1.0f, alpha; f32x16 o[2] = {};
#pragma unroll 1
        for (int kt = 0; kt < 4; ++kt) { const int k0 = T0 - 128 + 64 * kt;
            if (k0 < 0 || k0 > r0 + 31 || k0 + 63 < r0 - 127) continue;
            LAS const float* lp = lut + g * 384 + 128 + (qpos - k0 - 4 * hi) - 63;
            f32x16 p0, p1;
#pragma unroll
            for (int r = 0; r < 16; ++r) { const int c = (r & 3) + 8 * (r >> 2); p0[r] = lp[63 - c]; p1[r] = lp[31 - c]; }
            qkt64(p0, p1, K_lds + kt * 8192, r32, hi, qr);
            bf16x8 pa0, pa1, pa2, pa3;
            softmax_tile(p0, p1, m_reg, l_reg, alpha, pa0, pa1, pa2, pa3);
            RESC(2);
            pv_tile<2>(o, vb0 + kt * 8192, pa0, pa1, pa2, pa3);
        }
        bf16* Ow = (bf16*)(F.ws + WS_BR) + (rowb + r0) * DM + 1536 + head * 64;
        store_o<2>(o, l_reg, li_l, Ow, r32, hi);
    }
    __syncthreads();
}
#undef RESC
}

__device__ __forceinline__ void conv_unit(Frame& F, const Args& a, int l, int cu) {
    const int c = opaque_v(F.tid_()), lane = c & 63, wave = __builtin_amdgcn_readfirstlane(c >> 6); const int m0 = cu * 32, t0 = m0 % SEQ;
    const bf16* PJ = (const bf16*)(F.ws + WS_PJ);
    LAS float* cv = (LAS float*)F.lds;
    float w[31];
#pragma unroll
    for (int j = 0; j < 31; ++j) w[j] = a.conv_w[(size_t)l * 31 * 512 + j * 512 + c];
    const float cb = a.conv_b[l * 512 + c];
    float in[62];
#pragma unroll
    for (int i = 0; i < 62; ++i) { const int t = t0 - 30 + i; in[i] = t >= 0 ? __builtin_bit_cast(float, (unsigned)PJ[(size_t)(m0 - 30 + i) * LDP + PJ_GLU + c] << 16) : 0.f; }
#pragma unroll
    for (int t = 0; t < 32; ++t) { float s = cb;
#pragma unroll
        for (int j = 0; j < 31; ++j) s += w[j] * in[t + j];
        cv[t * 512 + c] = s; }
    __syncthreads();
    const float* lg = a.conv_g + l * 512; const float* lb = a.conv_beta + l * 512;
    bf16* BR = (bf16*)(F.ws + WS_BR);
#pragma unroll 1
    for (int rr = 0; rr < 4; ++rr) { const int t = wave * 4 + rr;
        const f32x4 v0 = *(LAS const f32x4*)(cv + t * 512 + 8 * lane), v1 = *(LAS const f32x4*)(cv + t * 512 + 8 * lane + 4);
        float s = (v0.x + v0.y) + (v0.z + v0.w) + (v1.x + v1.y) + (v1.z + v1.w);
        const float mu = wave_sum(s) * (1.0f / 512.0f);
        const f32x4 d0 = v0 - mu, d1 = v1 - mu;
        float q = (d0.x * d0.x + d0.y * d0.y) + (d0.z * d0.z + d0.w * d0.w) + (d1.x * d1.x + d1.y * d1.y) + (d1.z * d1.z + d1.w * d1.w);
        const float rs = 1.0f / sqrtf(wave_sum(q) * (1.0f / 512.0f) + LN_EPS);
        const f32x4 g0 = *(const f32x4*)(lg + 8 * lane), g1 = *(const f32x4*)(lg + 8 * lane + 4), b0 = *(const f32x4*)(lb + 8 * lane), b1 = *(const f32x4*)(lb + 8 * lane + 4);
        f32x4 y0 = d0 * rs * g0 + b0, y1 = d1 * rs * g1 + b1;
#pragma unroll
        for (int k = 0; k < 4; ++k) { y0[k] = y0[k] * fsigmoid(y0[k]); y1[k] = y1[k] * fsigmoid(y1[k]); }
        u32x4 o; o.x = pk2(y0.x, y0.y); o.y = pk2(y0.z, y0.w); o.z = pk2(y1.x, y1.y); o.w = pk2(y1.z, y1.w);
        *(u32x4*)(BR + (size_t)(m0 + t) * DM + 1024 + 8 * lane) = o; }
    __syncthreads();
}

constexpr int NU_ATTQ = 64, NU_SWA = 256, NU_CONV = 512, NU_REST = NU_SWA + NU_CONV;
__device__ __forceinline__ void mixer_phase(Frame& F, const Args& a, int l) {
    gu32* heads = F.ctl + CW_QUEUE + 64 * 16 * l;
    LAS unsigned* slot = (LAS unsigned*)(F.lds + RING_BYTES + 128);
    const int x = (int)(xb_xcc_id() & 7u);
    for (int s = 0; s < 8; ++s) {
        const int qq = (x + s) & 7;
        for (;;) {
            if (F.tid_() == 0) slot[0] = __hip_atomic_fetch_add(heads + 64 * qq, 1u, RLX_AGENT);
            __syncthreads();
            const int idx = (int)slot[0];
            __syncthreads();
            if (idx >= NU_ATTQ) break;
            const int qb = 31 - (idx >> 1), kind = idx & 1;
            if (kind == 1) { if (PH_EN(9)) att::moba_unit(F, a, l, qq >> 2, qq & 3, qb); } else { if (PH_EN(8)) att::attn128_unit<0>(F, a, l, qq >> 2, qq & 3, qb); }
        }
    }
    for (;;) {
        if (F.tid_() == 0) slot[0] = __hip_atomic_fetch_add(heads + 64 * 8, 1u, RLX_AGENT);
        __syncthreads();
        const int idx = (int)slot[0];
        __syncthreads();
        if (idx >= NU_REST) break;
        if (idx < NU_SWA) { if (PH_EN(10)) att::swa_unit(F, a, l, idx >> 7, (idx >> 6) & 1, idx & 63); }
        else { if (PH_EN(11)) conv_unit(F, a, l, idx - NU_SWA); }
    }
}

constexpr int NPHASE = 1 + 8 * DEPTH + 1;
__global__ void __launch_bounds__(512, 2) fwd(Args args) {
    extern __shared__ __attribute__((aligned(16))) unsigned char lds_raw[];
    Frame F;
    F.lds = (LAS unsigned char*)lds_raw; F.MISC = (volatile LAS unsigned*)(F.lds + MISC_OFF);
    F.wave = __builtin_amdgcn_readfirstlane((int)threadIdx.x >> 6); F.G = gridDim.x;
    F.ws = args.ws; F.ctl = (gu32*)(args.ws + WS_CTL);
    for (int u = F.tid_(); u < (LDS_BYTES - RING_BYTES) / 4; u += 512) ((LAS unsigned*)(F.lds + RING_BYTES))[u] = 0u;
    __syncthreads();
    XcdBarrier bar; bar.bar = (unsigned*)(F.ctl + CW_BAR); bar.x = 0; bar.st = nullptr; bar.wave = F.wave;
    const bool one_launch = (args.ph_hi - args.ph_lo) > 1;
    if (one_launch) bar = xcd_barrier_post((unsigned*)(F.ctl + CW_BAR), F.MISC + 8, F.wave);
    const int lo = args.ph_lo, hi = args.ph_hi;
#define IN(k) (lo <= (k) && (k) < hi)
#define SEAM(k) do { if (IN(k) && IN((k) + 1)) xcd_barrier(bar); } while (0)
    float* MOD = (float*)(args.ws + WS_MOD);
    bf16* HY = (bf16*)(args.ws + WS_HY); bf16* PJb = (bf16*)(args.ws + WS_PJ); bf16* GT = (bf16*)(args.ws + WS_GT);
    bf16* BR = (bf16*)(args.ws + WS_BR); bf16* YO = BR; bf16* MID = GT;

#ifdef DBG_STOP
    if (lo >= 100) {
        const int code = lo - 100; const bf16* src; int pitch;
        if (code == 0) { src = HY; pitch = DM; } else if (code == 1) { src = PJb; pitch = LDP; } else if (code == 2) { src = GT; pitch = 8192; } else if (code == 3) { src = BR; pitch = DM; }
        else if (code == 4) { src = MID; pitch = DFF; } else if (code == 5) { src = PJb + 2304; pitch = LDP; } else if (code == 6) { src = GT + 6144; pitch = 8192; } else { src = MID + 3584; pitch = DFF; }
        for (size_t i = (size_t)bid_fresh() * 512 + F.tid_(); i < (size_t)M * DM; i += (size_t)F.G * 512) { const size_t r = i / DM, c = i % DM; args.out[i] = __builtin_bit_cast(float, (unsigned)src[r * pitch + c] << 16); }
        return;
    }
#endif
    if (PH_EN(0) && IN(0)) { p0_prologue(F, args); } SEAM(0);

#pragma unroll 1
    for (int l = 0; l < DEPTH; ++l) {
        const int pb = 1 + 8 * l;
        unsigned char* wl = args.ws + WS_W + (size_t)l * W_LAYER;
        const float* modl = MOD + (size_t)l * 2 * 12288;
        if (l == 0) {
            if (PH_EN(1) && IN(pb)) { if (bid_fresh() == 0) h2_scales(F, args);
                NormArgs n{}; n.xin = args.x; n.hout = nullptr; n.lf = (float*)(args.ws + WS_LF);
                n.nx_gain = args.mix_pre; n.nx_scale = modl + 2048; n.nx_shift = modl; n.wf = args.w_in; n.fox_b = args.fox_bias; n.flags = 2 | 4; n.h8 = (unsigned char*)HY; n.hr = (float*)(args.ws + WS_HR);
                norm_phase(F, n); }
        }
        SEAM(pb);
        if (PH_EN(2) && IN(pb + 1)) {
            if (bid_fresh() >= 192 && bid_fresh() < 200) fox_scan(F, bid_fresh() - 192);
#ifdef DBG_FILL
            { const u32x4* src = (const u32x4*)(HY + (size_t)bid_fresh() * 64 * DM); u32x4* dst = (u32x4*)(BR + (size_t)bid_fresh() * 64 * DM);
              for (int i = F.tid_(); i < 64 * DM / 8; i += 512) dst[i] = src[i]; }
#endif
            { typedef pg8::Dims<DM / 2, DM / 2, DM / 2, 64, 19, 1, 0, 0> D;
              pg8::Gemm g{HY, (const bf16*)(wl + W_IN)};
              pg8::TileOrder<D> S{F.G, (int)bid_fresh()};
              pg8::EpiProj E{PJb, GT, (bf16*)(args.ws + WS_KF), (bf16*)(args.ws + WS_VF), (float*)(args.ws + WS_CTL + CTL_KMEAN) + (size_t)l * 64 * 512, (unsigned*)(args.ws + WS_CTL) + CW_KN2 + l * 8 * 64,
                               (const float*)(args.ws + WS_HR), (const float*)(args.ws + WS_SG) + (size_t)l * 13056};
              pg8::gemm_phase<D>(F.lds, g, S, E, F.wave); }
            __syncthreads();
            { typedef pg8::Dims<DM / 2, DM / 2, DM / 2, 64, 32, 1, 0, 0> D;
              pg8::Gemm g{HY, (const bf16*)(wl + W_IN + (size_t)(19 * 256) * DM)};
              pg8::TileOrder<D> S{F.G, (int)bid_fresh()};
              pg8::EpiGate8 E{GT, (const float*)(args.ws + WS_HR), (const float*)(args.ws + WS_SG) + (size_t)l * 13056 + 19 * 256};
              pg8::gemm_phase<D>(F.lds, g, S, E, F.wave); }
        }
        SEAM(pb + 1);
        if (PH_EN(3) && IN(pb + 2)) mixer_phase(F, args, l);
        SEAM(pb + 2);
        if (PH_EN(4) && IN(pb + 3)) {
            typedef pg8::Dims<DM, DM, DM, 64, 8, 1, 0, 0> D;
            pg8::Gemm g{BR, (const bf16*)(wl + W_BR)};
            pg8::TileOrder<D> S{F.G, (int)bid_fresh()};
            pg8::EpiMerge E{(const unsigned char*)GT, HY};
            pg8::gemm_phase<D>(F.lds, g, S, E, F.wave);
        }
        SEAM(pb + 3);
        if (PH_EN(5) && IN(pb + 4)) {
            typedef pg8::Dims<DM, DM, DM, 64, 8, 1, 0, 0> D;
            pg8::Gemm g{HY, (const bf16*)(wl + W_OUT)};
            float* xs = (float*)(args.ws + WS_XS); gu32* xc = F.ctl + (CTL_XCNT / 4);
            pg8::EpiResNorm E{};
            if (l == 0) { E.xf32 = args.x; E.xo = (bf16*)args.out; E.xo_pitch = 2 * DM; E.xo_off = DM; }
            else { E.xb = (const bf16*)args.out; E.xb_pitch = 2 * DM; E.xb_off = DM; E.xo = YO; E.xo_pitch = DM; E.xo_off = 0; }
            E.res_gate = modl + 4096; E.res_gain = args.mix_post + l * DM;
            E.hout = PJb; E.nx_gain = args.ffn_pre + l * DM; E.nx_scale = modl + 8192; E.nx_shift = modl + 6144; E.hs = (const float*)(args.ws + WS_HS) + l * 2;
            E.ex1 = pg8::RowX{xs + (size_t)(l * 4 + 0) * 64 * 256 * 8, xc + (l * 4 + 0) * 64 * 16, F.ctl + 2};
            E.ex2 = pg8::RowX{xs + (size_t)(l * 4 + 1) * 64 * 256 * 8, xc + (l * 4 + 1) * 64 * 16, F.ctl + 2};
#pragma unroll 1
            for (int sl = 0; sl < 2; ++sl) { pg8::SliceOrder<D> S{sl, (int)bid_fresh()}; pg8::gemm_phase<D>(F.lds, g, S, E, F.wave); __syncthreads(); }
        }
        SEAM(pb + 4);
        if (PH_EN(6) && IN(pb + 6)) {
            typedef pg8::Dims<DM / 2, DM / 2, DM / 2, 64, 44, 1, 0, 0> D;
            pg8::Gemm g{PJb, (const bf16*)(wl + W_GU)};
            pg8::TileOrder<D> S{F.G, (int)bid_fresh()};
            pg8::EpiSwiGLU E{MID, DFF, (const float*)(args.ws + WS_SW) + (size_t)l * 2 * DFF, (const float*)(args.ws + WS_HS) + l * 2};
            pg8::gemm_phase<D>(F.lds, g, S, E, F.wave);
        }
        SEAM(pb + 6);
        if (PH_EN(7) && IN(pb + 7)) {
            typedef pg8::Dims<64, DFF, DFF, 64, 8, 1, 0, 0, 32768, (long)DFF * 256 * 2> D;
            pg8::Gemm g{MID, (const bf16*)(wl + W_DN)};
            if (l + 1 < DEPTH) {
                pg8::TileOrder<D> S{F.G, (int)bid_fresh()};
                pg8::EpiBf16 E{YO, DM};
                pg8::gemm_phase<D>(F.lds, g, S, E, F.wave);
            } else {
                float* xs = (float*)(args.ws + WS_XS); gu32* xc = F.ctl + (CTL_XCNT / 4);
                pg8::EpiResNorm E{};
                E.xb = YO; E.xb_pitch = DM; E.xb_off = 0; E.outf = args.out;
                E.res_gate = modl + 10240; E.res_gain = args.ffn_post + l * DM;
                E.ex1 = pg8::RowX{xs + (size_t)(l * 4 + 2) * 64 * 256 * 8, xc + (l * 4 + 2) * 64 * 16, F.ctl + 2};
#pragma unroll 1
                for (int sl = 0; sl < 2; ++sl) { pg8::SliceOrder<D> S{sl, (int)bid_fresh()}; pg8::gemm_phase<D>(F.lds, g, S, E, F.wave); __syncthreads(); }
            }
        }
        if (l + 1 < DEPTH) {
        SEAM(pb + 7);
        if (PH_EN(1) && IN(pb + 8)) { NormArgs n{}; n.xin = args.out; n.xout = args.out; n.yo = YO; n.hout = nullptr; n.lf = (float*)(args.ws + WS_LF);
            n.res_gate = modl + 10240; n.res_gain = args.ffn_post + l * DM;
            const float* modn = MOD + (size_t)(l + 1) * 2 * 12288;
            n.nx_gain = args.mix_pre + (l + 1) * DM; n.nx_scale = modn + 2048; n.nx_shift = modn; n.wf = args.w_in + (size_t)(l + 1) * DM * INW; n.fox_b = args.fox_bias + (l + 1) * 4; n.flags = 1 | 2 | 4 | 8 | 16; n.h8 = (unsigned char*)HY; n.hr = (float*)(args.ws + WS_HR);
            norm_phase(F, n); }
        }
    }
#undef IN
#undef SEAM
}

extern "C" void kernel_launch(void* const* d_in, const int* in_sizes, int n_in, void* d_out, int out_size, void* d_ws, size_t ws_size, hipStream_t stream) {
    static int grid = 0;
    if (grid == 0) {
        if (n_in != 24 || in_sizes[0] != M * DM || out_size != M * DM || ws_size < WS_END) {
            fprintf(stderr, "kernel_launch: unexpected shapes (n_in %d, in0 %d, out %d, ws %zu < %zu?)\n", n_in, n_in > 0 ? in_sizes[0] : -1, out_size, ws_size, (size_t)WS_END); grid = -1; return; }
        int dev = 0, cus = 0, per_cu = 0;
        if (hipGetDevice(&dev) != hipSuccess || hipDeviceGetAttribute(&cus, hipDeviceAttributeMultiprocessorCount, dev) != hipSuccess) { grid = -1; return; }
        if (hipFuncSetAttribute((const void*)fwd, hipFuncAttributeMaxDynamicSharedMemorySize, LDS_BYTES) != hipSuccess) { fprintf(stderr, "kernel_launch: hipFuncSetAttribute failed\n"); grid = -1; return; }
        if (hipOccupancyMaxActiveBlocksPerMultiprocessor(&per_cu, (const void*)fwd, 512, LDS_BYTES) != hipSuccess || per_cu < 1) { fprintf(stderr, "kernel_launch: occupancy query says %d\n", per_cu); }
        (void)hipGetLastError();
        grid = cus;
        if (grid != 256) { fprintf(stderr, "kernel_launch: the fused epilogues assume 256 CUs, found %d\n", grid); grid = -1; return; }
    }
    if (grid < 0) return;
    if (hipMemsetAsync((char*)d_ws + WS_CTL, 0, CTL_ZERO_BYTES, stream) != hipSuccess) return;
    Args a{};
    const float** ap = (const float**)&a;
    for (int i = 0; i < 24; ++i) ap[i] = (const float*)d_in[i];
    a.out = (float*)d_out; a.ws = (unsigned char*)d_ws;
#if defined(DBG_STOP)
    for (int p = 0; p <= DBG_STOP; ++p) { a.ph_lo = p; a.ph_hi = p + 1; hipLaunchKernelGGL(fwd, dim3(grid), dim3(512), LDS_BYTES, stream, a); }
    a.ph_lo = 100 + DBG_SRC; a.ph_hi = 101 + DBG_SRC; hipLaunchKernelGGL(fwd, dim3(grid), dim3(512), LDS_BYTES, stream, a);
#elif MK_PER_PHASE
    for (int p = 0; p < NPHASE; ++p) {
        a.ph_lo = p; a.ph_hi = p + 1;
        hipLaunchKernelGGL(fwd, dim3(grid), dim3(512), LDS_BYTES, stream, a);
    }
#else
    a.ph_lo = 0; a.ph_hi = NPHASE;
    hipLaunchKernelGGL(fwd, dim3(grid), dim3(512), LDS_BYTES, stream, a);
#endif
}
```
